# Optimizing an MI355X kernel written in HIP

```python
import math
import jax, jax.numpy as jnp
from jax import lax
import numpy as np

D_MODEL = 1024
BATCH = 8
SEQ = 4096
DEPTH = 4

N_META = 16
EXPAND = 2
D_INNER = EXPAND * D_MODEL
GLA_HEADS = 4
GLA_DK = D_INNER // 2
GLA_DV = D_INNER
GLA_HK = GLA_DK // GLA_HEADS
GLA_HV = GLA_DV // GLA_HEADS
GLA_RANK = 16
GLA_TAU = 16.0
GLA_CHUNK = 64
GLA_PROJ = 2 * GLA_DK + GLA_DV + D_INNER + GLA_RANK
DIFF_HEAD_DIM = 128
DIFF_HEADS = D_INNER // (2 * DIFF_HEAD_DIM)
DIFF_PROJ = 4 * D_INNER
DIFF_QBLOCK = 128
REL_BUCKETS = 32
REL_MAX_EXACT = 16
REL_MAX_DIST = 128
EPS = 1e-6
N_GLA = (DEPTH + 1) // 2
N_DIFF = DEPTH // 2

kernel_name = "hybrid_gla_diffattn_meta_trunk"


def rmsnorm(x, g):
    xf = x.astype(jnp.float32)
    y = xf * lax.rsqrt(jnp.mean(xf * xf, axis=-1, keepdims=True) + EPS)
    return (y * g.astype(jnp.float32)).astype(x.dtype)


def head_rms(o):
    return o * lax.rsqrt(jnp.mean(o * o, axis=-1, keepdims=True) + EPS)


def gla_chunk(S, inp):
    q, k, v, lg = inp
    c = q.shape[2]
    b = jnp.cumsum(lg, axis=2)
    causal = jnp.tril(jnp.ones((c, c), dtype=bool))
    rel = b[:, :, :, None, :] - b[:, :, None, :, :]
    decay = jnp.exp(jnp.where(causal[:, :, None], rel, -jnp.inf))
    attn = jnp.einsum('bhid,bhjd,bhijd->bhij', q, k, decay)
    o = (jnp.einsum('bhij,bhjv->bhiv', attn, v)
         + jnp.einsum('bhid,bhdv->bhiv', q * jnp.exp(b), S))
    b_last = b[:, :, -1:, :]
    S_new = (jnp.exp(b_last[:, :, 0, :])[..., None] * S
             + jnp.einsum('bhjd,bhjv->bhdv', k * jnp.exp(b_last - b), v))
    return S_new, o


def gla_branch(xn, w_in, w_gate_up, b_gate, gnorm, w_out):
    B, L, _ = xn.shape
    f32 = jnp.float32
    proj = xn @ w_in
    q, k, v, z, g_lr = jnp.split(
        proj, [GLA_DK, 2 * GLA_DK, 2 * GLA_DK + GLA_DV, 2 * GLA_DK + GLA_DV + D_INNER], axis=-1)
    lg = jax.nn.log_sigmoid((g_lr @ w_gate_up + b_gate).astype(f32)) / GLA_TAU

    def heads(t, hd):
        return t.astype(f32).reshape(B, L, GLA_HEADS, hd).transpose(0, 2, 1, 3)

    q = heads(q, GLA_HK) * (GLA_HK ** -0.5)
    k, lg, v = heads(k, GLA_HK), heads(lg, GLA_HK), heads(v, GLA_HV)

    S0 = jnp.zeros((B, GLA_HEADS, GLA_HK, GLA_HV), f32)
    S1, o_meta = gla_chunk(S0, (q[:, :, :N_META], k[:, :, :N_META],
                                v[:, :, :N_META], lg[:, :, :N_META]))
    n_chunks = (L - N_META) // GLA_CHUNK

    def chunks(t):
        t = t[:, :, N_META:]
        return jnp.moveaxis(t.reshape(B, GLA_HEADS, n_chunks, GLA_CHUNK, t.shape[-1]), 2, 0)

    _, o_real = lax.scan(gla_chunk, S1, (chunks(q), chunks(k), chunks(v), chunks(lg)))
    o_real = jnp.moveaxis(o_real, 0, 2).reshape(B, GLA_HEADS, L - N_META, GLA_HV)
    o = jnp.concatenate([o_meta, o_real], axis=2)
    o = head_rms(o.transpose(0, 2, 1, 3)).reshape(B, L, D_INNER) * gnorm.astype(f32)
    y = jax.nn.silu(z.astype(f32)) * o
    return (y.astype(xn.dtype) @ w_out)


def t5_bucket(n):
    nf = jnp.maximum(n, 1).astype(jnp.float32)
    large = REL_MAX_EXACT + (jnp.log(nf / REL_MAX_EXACT)
                             / math.log(REL_MAX_DIST / REL_MAX_EXACT)
                             * (REL_BUCKETS - REL_MAX_EXACT)).astype(jnp.int32)
    large = jnp.minimum(large, REL_BUCKETS - 1)
    return jnp.where(n < REL_MAX_EXACT, n, large)


def diff_branch(xn, w_in, lam_vecs, gnorm, w_out, rel_table, lambda_init):
    B, L, _ = xn.shape
    H, d = DIFF_HEADS, DIFF_HEAD_DIM
    f32 = jnp.float32
    proj = xn @ w_in
    q, k, v, z = jnp.split(proj, 4, axis=-1)
    lv = lam_vecs.astype(f32)
    lam = jnp.exp(jnp.sum(lv[0] * lv[1])) - jnp.exp(jnp.sum(lv[2] * lv[3])) + lambda_init

    n_blocks = -(-L // DIFF_QBLOCK)
    Lp = n_blocks * DIFF_QBLOCK
    pad = ((0, 0), (0, Lp - L), (0, 0))
    q = jnp.pad(q.astype(f32), pad).reshape(B, n_blocks, DIFF_QBLOCK, H, 2, d)
    q_blocks = q.transpose(1, 0, 3, 4, 2, 5)
    kh = jnp.pad(k.astype(f32), pad).reshape(B, Lp, H, 2, d).transpose(0, 2, 3, 1, 4)
    vh = jnp.pad(v.astype(f32), pad).reshape(B, Lp, H, 2 * d).transpose(0, 2, 1, 3)
    table = rel_table.astype(f32)
    kpos = jnp.arange(Lp, dtype=jnp.int32)
    scale = d ** -0.5

    def block(args):
        qb, start = args
        qpos = start + jnp.arange(DIFF_QBLOCK, dtype=jnp.int32)
        dist = qpos[:, None] - kpos[None, :]
        bias = jnp.moveaxis(table[t5_bucket(jnp.maximum(dist, 0))], -1, 0)
        s = jnp.einsum('bhpqd,bhpkd->bhpqk', qb, kh) * scale + bias[None, :, None]
        s = jnp.where(dist >= 0, s, -jnp.inf)
        p = jax.nn.softmax(s, axis=-1)
        a = p[:, :, 0] - lam * p[:, :, 1]
        return jnp.einsum('bhqk,bhkv->bhqv', a, vh)

    starts = jnp.arange(n_blocks, dtype=jnp.int32) * DIFF_QBLOCK
    o = lax.map(block, (q_blocks, starts))
    o = o.transpose(1, 0, 3, 2, 4).reshape(B, Lp, H, 2 * d)[:, :L]
    o = head_rms(o) * gnorm.astype(f32) * (1.0 - lambda_init)
    y = jax.nn.silu(z.astype(f32)) * o.reshape(B, L, D_INNER)
    return (y.astype(xn.dtype) @ w_out)


def setup_inputs(seed: int = 0) -> dict:
    key = jax.random.key(seed)
    ks = jax.random.split(key, 16)
    nrm = jax.random.normal
    f32 = jnp.float32
    return {
        "x": nrm(ks[0], (BATCH, SEQ, D_MODEL), f32),
        "meta": nrm(ks[1], (N_META, D_MODEL), f32),
        "g_norm": 1.0 + 0.02 * nrm(ks[2], (DEPTH, D_MODEL), f32),
        "gla_w_in": nrm(ks[3], (N_GLA, D_MODEL, GLA_PROJ), f32) * D_MODEL ** -0.5,
        "gla_w_gate_up": nrm(ks[4], (N_GLA, GLA_RANK, GLA_DK), f32) * GLA_RANK ** -0.5,
        "gla_b_gate": 0.1 * nrm(ks[5], (N_GLA, GLA_DK), f32),
        "gla_gnorm": 1.0 + 0.02 * nrm(ks[6], (N_GLA, D_INNER), f32),
        "gla_w_out": nrm(ks[7], (N_GLA, D_INNER, D_MODEL), f32) * D_INNER ** -0.5,
        "diff_w_in": nrm(ks[8], (N_DIFF, D_MODEL, DIFF_PROJ), f32) * D_MODEL ** -0.5,
        "diff_lam": 0.1 * nrm(ks[9], (N_DIFF, 4, DIFF_HEAD_DIM), f32),
        "diff_gnorm": 1.0 + 0.02 * nrm(ks[10], (N_DIFF, 2 * DIFF_HEAD_DIM), f32),
        "diff_w_out": nrm(ks[11], (N_DIFF, D_INNER, D_MODEL), f32) * D_INNER ** -0.5,
        "rel_bias": 0.5 * nrm(ks[12], (REL_BUCKETS, DIFF_HEADS), f32),
        "g_final": 1.0 + 0.02 * nrm(ks[13], (D_MODEL,), f32),
    }


def reference(x, meta, g_norm, gla_w_in, gla_w_gate_up, gla_b_gate, gla_gnorm, gla_w_out,
              diff_w_in, diff_lam, diff_gnorm, diff_w_out, rel_bias, g_final):
    B = x.shape[0]
    h = jnp.concatenate([jnp.broadcast_to(meta.astype(x.dtype)[None], (B, N_META, D_MODEL)), x], axis=1)
    gi = 0
    di = 0
    for i in range(DEPTH):
        hn = rmsnorm(h, g_norm[i])
        if i % 2 == 0:
            y = gla_branch(hn, gla_w_in[gi], gla_w_gate_up[gi], gla_b_gate[gi],
                           gla_gnorm[gi], gla_w_out[gi])
            gi += 1
        else:
            lambda_init = 0.8 - 0.6 * math.exp(-0.3 * i)
            y = diff_branch(hn, diff_w_in[di], diff_lam[di], diff_gnorm[di], diff_w_out[di],
                            rel_bias, lambda_init)
            di += 1
        h = h + y.astype(h.dtype)
    return rmsnorm(h[:, N_META:], g_final)
```

```cpp
#include <hip/hip_runtime.h>
#include <hip/hip_cooperative_groups.h>
#include <cstdio>
namespace cg = cooperative_groups;

#define DBG_LAST 21
#define DBG_SKIP 0x0
#ifndef DBG_DOUBLE
#define DBG_DOUBLE 0x0
#endif
#define DRY(rep) ((((DBG_DOUBLE >> kind) & 1) != 0) && (rep) == 0)
#ifndef MULTI_LAUNCH
#define MULTI_LAUNCH 0
#endif

#ifndef ONLY
#define ONLY -1
#endif
#define EN(k) (ONLY == -1 || ONLY == (k))
#define DI __device__ __forceinline__
#define LAS __attribute__((address_space(3)))
typedef unsigned short bf16_t;
typedef short bf16x8 __attribute__((ext_vector_type(8)));
typedef short s16x4 __attribute__((ext_vector_type(4)));
typedef float f32x4 __attribute__((ext_vector_type(4)));
typedef float f32x16 __attribute__((ext_vector_type(16)));
typedef unsigned u32x4 __attribute__((ext_vector_type(4)));
typedef unsigned u32x2 __attribute__((ext_vector_type(2)));

constexpr int MREG = 32768;
constexpr int RCONT = MREG + 64;
constexpr size_t RALLOC = MREG + 128;
constexpr size_t WS_HMETA = 0;
constexpr size_t WS_BIAS = 65536;
constexpr size_t WS_OMETA = 65536 + 8192;
constexpr size_t WS_BAR = 196608;
constexpr size_t WS_WIN = 262144;
constexpr size_t WS_WOUT = WS_WIN + 16777216;
constexpr size_t WS_WG = WS_WOUT + 4194304;
constexpr size_t WS_HN = WS_WG + 32768;
constexpr size_t WS_ACT = WS_HN + RALLOC * 2048;
constexpr size_t WS_ATTN = WS_ACT + RALLOC * 12288;
constexpr size_t WS_E = WS_ATTN + (size_t)513 * 4 * 4096 * 2;
constexpr size_t WS_GLR = WS_E + (size_t)513 * 4 * 256 * 4;
constexpr size_t WS_END = WS_GLR + RALLOC * 64;
constexpr int LDS_BYTES = 147456;
constexpr int NPHASES = 23;

struct Params {
    const float *x, *meta, *g_norm, *gla_w_in, *gla_wgu, *gla_bg, *gla_gn, *gla_w_out, *diff_w_in, *diff_lam, *diff_gn, *diff_w_out, *rel_bias, *g_final;
    float* out; unsigned char* ws; int ph_lo, ph_hi;
};

DI int opaque_bid() { int b = blockIdx.x; asm volatile("" : "+s"(b)); return b; }
DI int opaque_gdim() { int g = gridDim.x; asm volatile("" : "+s"(g)); return g; }
DI int hw_lane() { unsigned z = 0u; asm volatile("" : "+s"(z)); return (int)__builtin_amdgcn_mbcnt_hi(~0u, __builtin_amdgcn_mbcnt_lo(~0u, z)); }
DI int opaque_tid(int wid0) { int w = wid0; asm volatile("" : "+s"(w)); return w * 64 + hw_lane(); }
typedef __bf16 bf16v2_t __attribute__((ext_vector_type(2)));
typedef float f32x2_t __attribute__((ext_vector_type(2)));
DI unsigned cvt_pk_bf16(float lo, float hi) { const f32x2_t v = {lo, hi}; const bf16v2_t b = __builtin_convertvector(v, bf16v2_t); return __builtin_bit_cast(unsigned, b); }
DI float bf2f(short b) { return __uint_as_float(((unsigned)(unsigned short)b) << 16); }
#define SWZ_XOR(v, x) __int_as_float(__builtin_amdgcn_ds_swizzle(__float_as_int(v), 0x1F | ((x) << 10)))
DI float half_sum(float v) { v += SWZ_XOR(v, 1); v += SWZ_XOR(v, 2); v += SWZ_XOR(v, 4); v += SWZ_XOR(v, 8); v += SWZ_XOR(v, 16); return v; }
DI float wave_sum(float v) { v = half_sum(v); auto rr = __builtin_amdgcn_permlane32_swap(__float_as_uint(v), __float_as_uint(v), false, false); return __uint_as_float(rr[0]) + __uint_as_float(rr[1]); }
DI int crow(int r, int hi) { return (r & 3) + 8 * (r >> 2) + 4 * hi; }
#define MFMA16(a, b, c) __builtin_amdgcn_mfma_f32_16x16x32_bf16((a), (b), (c), 0, 0, 0)
#define MFMA32(a, b, c) __builtin_amdgcn_mfma_f32_32x32x16_bf16((a), (b), (c), 0, 0, 0)

namespace pg8 {
constexpr int BM = 256, BK = 64, HALF = 128, HTB = HALF * BK * 2, STAGE_BYTES = 8 * HTB, NXCD = 8, WGM = 8;
DI int lds_byte(int r, int c) { const int st = (r >> 4) * 2 + (c >> 5), rr = r & 15, cc = c & 31, ob = rr * 64 + cc * 2; return st * 1024 + (ob ^ (((ob >> 9) & 1) << 5)); }
DI void stage_rc(int b, int& R, int& C) { const int st = b / 1024, sb = b % 1024, swz = sb ^ (((sb >> 9) & 1) << 5); R = (st >> 1) * 16 + swz / 64; C = (st & 1) * 32 + (swz % 64) / 2; }
DI int perm32(int rho) { const int n = rho >> 4, i = rho & 15; return 8 * (i >> 2) + 4 * n + (i & 3); }
struct Unit { int pm, pn; };
struct Gemm { const bf16_t* A; const bf16_t* Bt; int M, N, K; };
struct StaticOrder {
    int nM, nN, nwg, G, c;
    DI void init(int M, int N, int G_, int c_) { nM = M / BM; nN = N / BM; nwg = nM * nN; G = G_; c = c_; }
    DI bool next(int i, Unit& u) const {
        const long L = (long)i * G + c; if (L >= nwg) return false;
        int wgid = (int)L; { const int q = nwg / NXCD, r = nwg % NXCD, xcd = wgid % NXCD, off = wgid / NXCD; wgid = (xcd < r ? xcd * (q + 1) : r * (q + 1) + (xcd - r) * q) + off; }
        const int nig = WGM * nN, gid = wgid / nig, fm = gid * WGM, gsz = (nM - fm) < WGM ? (nM - fm) : WGM;
        u.pm = fm + ((wgid % nig) % gsz); u.pn = (wgid % nig) / gsz; return true;
    }
};
template <class F> struct EpiGen {
    F f;
    DI void operator()(const f32x4 (&acc)[2][2][4][2], const Unit& u, int wr, int wc, int fr, int fq) const {
        const int row0 = u.pm * BM + wr * 64 + fr, col0 = u.pn * BM + wc * 32 + 8 * fq;
#pragma unroll
        for (int ai = 0; ai < 2; ++ai)
#pragma unroll
            for (int m = 0; m < 4; ++m)
#pragma unroll
                for (int bj = 0; bj < 2; ++bj) f.store8(row0 + ai * HALF + m * 16, col0 + bj * HALF, acc[ai][bj][m][0], acc[ai][bj][m][1]);
    }
};

template <class Epi>
DI void gemm_phase(int wid0, LAS unsigned char* lds, const Gemm g, const StaticOrder& S, const Epi& E) {
    const int tid = opaque_tid(wid0), wid = __builtin_amdgcn_readfirstlane(tid >> 6), lane = tid & 63, wr = wid >> 2, wc = wid & 3, fr = lane & 15, fq = lane >> 4;
    const int K = g.K, nt = K / BK;
    unsigned voffA[2], voffB[2];
#pragma unroll
    for (int i = 0; i < 2; ++i) { int R, C; stage_rc(tid * 16 + i * 8192, R, C); const int Rb = (R & ~31) + perm32(R & 31); voffA[i] = (unsigned)(R * K + C) * 2u; voffB[i] = (unsigned)(Rb * K + C) * 2u; }
    const size_t kstep = (size_t)(BK * 2);
    const size_t hstep = (size_t)HALF * K * 2;
    const size_t tstep = 2 * hstep;
    const unsigned ldsw = (unsigned)wid * 1024u;
    const int aoff = lds_byte(wr * 64 + fr, fq * 8), boff = lds_byte(wc * 32 + fr, fq * 8);
#define PG8_SA(b, h) (((b) * 2 + (h)) * HTB)
#define PG8_SB(b, h) ((4 + (b) * 2 + (h)) * HTB)
#define PG8_STAGE(bufoff, gbase, voff) do { _Pragma("unroll") for (int _i = 0; _i < 2; ++_i) \
        __builtin_amdgcn_global_load_lds((const unsigned*)((const char*)(gbase) + (voff)[_i]), (LAS unsigned*)(lds + (bufoff) + ldsw + _i * 8192), 16, 0, 0); } while (0)
#define PG8_LDA(dst, b, h) do { _Pragma("unroll") for (int m = 0; m < 4; ++m) _Pragma("unroll") for (int k = 0; k < 2; ++k) dst[m][k] = *(const LAS bf16x8*)(lds + PG8_SA(b, h) + aoff + m * 2048 + k * 1024); } while (0)
#define PG8_LDB(dst, b, h) do { _Pragma("unroll") for (int n = 0; n < 2; ++n) _Pragma("unroll") for (int k = 0; k < 2; ++k) dst[n][k] = *(const LAS bf16x8*)(lds + PG8_SB(b, h) + boff + n * 2048 + k * 1024); } while (0)
#define PG8_MMA(ai, bj, At, Bt) do { __builtin_amdgcn_s_setprio(1); _Pragma("unroll") for (int m = 0; m < 4; ++m) _Pragma("unroll") for (int n = 0; n < 2; ++n) _Pragma("unroll") for (int k = 0; k < 2; ++k) \
        acc[ai][bj][m][n] = __builtin_amdgcn_mfma_f32_16x16x32_bf16(Bt[n][k], At[m][k], acc[ai][bj][m][n], 0, 0, 0); __builtin_amdgcn_s_setprio(0); } while (0)
#define PG8_WAIT_V(n) asm volatile("s_waitcnt vmcnt(" #n ")" ::: "memory")
#define PG8_WAIT_L(n) asm volatile("s_waitcnt lgkmcnt(" #n ")" ::: "memory")
#define PG8_BAR __builtin_amdgcn_s_barrier()
#define PG8_SCHED __builtin_amdgcn_sched_barrier(0)
    Unit cur, nxt; int ui = 0;
    if (!S.next(0, cur)) return;
    f32x4 acc[2][2][4][2];
#pragma unroll
    for (int a = 0; a < 2; ++a)
#pragma unroll
        for (int b = 0; b < 2; ++b)
#pragma unroll
            for (int m = 0; m < 4; ++m)
#pragma unroll
                for (int n = 0; n < 2; ++n) acc[a][b][m][n] = (f32x4){0.f, 0.f, 0.f, 0.f};
    bf16x8 At[4][2], B0[2][2], B1[2][2];
    const char* cA = (const char*)g.A + (size_t)cur.pm * tstep; const char* cB = (const char*)g.Bt + (size_t)cur.pn * tstep;
    PG8_STAGE(PG8_SB(0, 0), cB, voffB); PG8_STAGE(PG8_SB(0, 1), cB + hstep, voffB); PG8_STAGE(PG8_SA(0, 0), cA, voffA); PG8_STAGE(PG8_SA(0, 1), cA + hstep, voffA);
    if (wr == 1) PG8_BAR;
    PG8_WAIT_V(2); PG8_BAR;
    PG8_STAGE(PG8_SB(1, 0), cB + kstep, voffB); PG8_STAGE(PG8_SA(1, 0), cA + kstep, voffA); PG8_STAGE(PG8_SB(1, 1), cB + hstep + kstep, voffB);
    PG8_WAIT_V(6); PG8_BAR;
    for (;;) {
        const bool has_next = S.next(ui + 1, nxt);
        const char* nA = has_next ? (const char*)g.A + (size_t)nxt.pm * tstep : cA; const char* nB = has_next ? (const char*)g.Bt + (size_t)nxt.pn * tstep : cB;
        for (int t = 0; t < nt; t += 2) {
            const bool last = (t == nt - 2);
            const char* a1 = cA + (size_t)(t + 1) * kstep;
            const char* a2 = last ? nA : cA + (size_t)(t + 2) * kstep; const char* b2 = last ? nB : cB + (size_t)(t + 2) * kstep;
            const char* a3 = a2 + kstep; const char* b3 = b2 + kstep;
            PG8_LDB(B0, 0, 0); PG8_LDB(B1, 0, 1); PG8_SCHED; PG8_LDA(At, 0, 0); PG8_STAGE(PG8_SA(1, 1), a1 + hstep, voffA);
            PG8_WAIT_V(8); PG8_WAIT_L(0); PG8_BAR; PG8_MMA(0, 0, At, B0); PG8_MMA(0, 1, At, B1); PG8_BAR; PG8_SCHED;
            PG8_LDA(At, 0, 1); PG8_STAGE(PG8_SB(0, 0), b2, voffB); PG8_STAGE(PG8_SB(0, 1), b2 + hstep, voffB); PG8_STAGE(PG8_SA(0, 0), a2, voffA);
            PG8_WAIT_V(8); PG8_WAIT_L(0); PG8_BAR; PG8_MMA(1, 0, At, B0); PG8_MMA(1, 1, At, B1); PG8_BAR; PG8_SCHED;
            PG8_LDB(B0, 1, 0); PG8_LDB(B1, 1, 1); PG8_SCHED; PG8_LDA(At, 1, 0); PG8_STAGE(PG8_SA(0, 1), a2 + hstep, voffA);
            PG8_WAIT_V(8); PG8_WAIT_L(0); PG8_BAR; PG8_MMA(0, 0, At, B0); PG8_MMA(0, 1, At, B1); PG8_BAR; PG8_SCHED;
            PG8_LDA(At, 1, 1); PG8_STAGE(PG8_SB(1, 0), b3, voffB); PG8_STAGE(PG8_SB(1, 1), b3 + hstep, voffB); PG8_STAGE(PG8_SA(1, 0), a3, voffA);
            PG8_WAIT_V(8); PG8_WAIT_L(0); PG8_BAR; PG8_MMA(1, 0, At, B0); PG8_MMA(1, 1, At, B1); PG8_BAR; PG8_SCHED;
        }
        if (wr == 0) PG8_BAR;
        E(acc, cur, wr, wc, fr, fq);
        if (!has_next) break;
#pragma unroll
        for (int a = 0; a < 2; ++a)
#pragma unroll
            for (int b = 0; b < 2; ++b)
#pragma unroll
                for (int m = 0; m < 4; ++m)
#pragma unroll
                    for (int n = 0; n < 2; ++n) acc[a][b][m][n] = (f32x4){0.f, 0.f, 0.f, 0.f};
        cur = nxt; cA = nA; cB = nB; ++ui;
        if (wr == 1) PG8_BAR;
    }
    PG8_WAIT_V(0);
    PG8_BAR;
#undef PG8_SA
#undef PG8_SB
#undef PG8_STAGE
#undef PG8_LDA
#undef PG8_LDB
#undef PG8_MMA
#undef PG8_WAIT_V
#undef PG8_WAIT_L
#undef PG8_BAR
#undef PG8_SCHED
}
}

struct StGlaIn {
    bf16_t* act;
    DI void operator()(int row, int col, f32x4 a) const {
        bf16_t* d;
        if (col < 1024) d = act + (size_t)row * 1024 + col;
        else if (col < 2048) d = act + RALLOC * 1024 + (size_t)row * 1024 + (col - 1024);
        else if (col < 4096) d = act + RALLOC * 2048 + (size_t)row * 2048 + (col - 2048);
        else d = act + RALLOC * 4096 + (size_t)row * 2048 + (col - 4096);
        u32x2 w; w.x = cvt_pk_bf16(a[0], a[1]); w.y = cvt_pk_bf16(a[2], a[3]); *(u32x2*)d = w;
    }
    DI void store8(int row, int col, f32x4 a, f32x4 b) const {
        bf16_t* d;
        if (col < 1024) d = act + (size_t)row * 1024 + col;
        else if (col < 2048) d = act + RALLOC * 1024 + (size_t)row * 1024 + (col - 1024);
        else if (col < 4096) d = act + RALLOC * 2048 + (size_t)row * 2048 + (col - 2048);
        else d = act + RALLOC * 4096 + (size_t)row * 2048 + (col - 4096);
        u32x4 w; w.x = cvt_pk_bf16(a[0], a[1]); w.y = cvt_pk_bf16(a[2], a[3]); w.z = cvt_pk_bf16(b[0], b[1]); w.w = cvt_pk_bf16(b[2], b[3]); *(u32x4*)d = w;
    }
};
struct StDiffIn {
    bf16_t* act;
    DI void operator()(int row, int col, f32x4 a) const {
        bf16_t* d = act + (size_t)(col >> 11) * (RALLOC * 2048) + (size_t)row * 2048 + (col & 2047);
        u32x2 w; w.x = cvt_pk_bf16(a[0], a[1]); w.y = cvt_pk_bf16(a[2], a[3]); *(u32x2*)d = w;
    }
    DI void store8(int row, int col, f32x4 a, f32x4 b) const {
        bf16_t* d = act + (size_t)(col >> 11) * (RALLOC * 2048) + (size_t)row * 2048 + (col & 2047);
        u32x4 w; w.x = cvt_pk_bf16(a[0], a[1]); w.y = cvt_pk_bf16(a[2], a[3]); w.z = cvt_pk_bf16(b[0], b[1]); w.w = cvt_pk_bf16(b[2], b[3]); *(u32x4*)d = w;
    }
};
struct StZGate {
    bf16_t* o; bool dry;
    DI void operator()(int row, int col, f32x4 a) const {
        bf16_t* d = o + (size_t)row * 2048 + col;
        const u32x2 ov = *(const u32x2*)d;
        float of[4] = {__uint_as_float(ov.x << 16), __uint_as_float(ov.x & 0xffff0000u), __uint_as_float(ov.y << 16), __uint_as_float(ov.y & 0xffff0000u)};
        float y[4];
#pragma unroll
        for (int i = 0; i < 4; ++i) { const float z = a[i]; y[i] = z / (1.f + __expf(-z)) * of[i]; }
        u32x2 w; w.x = cvt_pk_bf16(y[0], y[1]); w.y = cvt_pk_bf16(y[2], y[3]); if (!dry) *(u32x2*)d = w;
    }
    DI void store8(int row, int col, f32x4 a, f32x4 b) const {
        bf16_t* d = o + (size_t)row * 2048 + col;
        const u32x4 ov = *(const u32x4*)d;
        const unsigned ow[4] = {ov.x, ov.y, ov.z, ov.w}; float y[8];
#pragma unroll
        for (int i = 0; i < 8; ++i) { const float z = i < 4 ? a[i] : b[i - 4]; const float of = (i & 1) ? __uint_as_float(ow[i >> 1] & 0xffff0000u) : __uint_as_float(ow[i >> 1] << 16); y[i] = z / (1.f + __expf(-z)) * of; }
        u32x4 w; w.x = cvt_pk_bf16(y[0], y[1]); w.y = cvt_pk_bf16(y[2], y[3]); w.z = cvt_pk_bf16(y[4], y[5]); w.w = cvt_pk_bf16(y[6], y[7]); if (!dry) *(u32x4*)d = w;
    }
};
struct StResid {
    const float* src; float* dst; int rowoff; bool dry;
    DI void operator()(int row, int col, f32x4 a) const {
        const size_t o = (size_t)(row - rowoff) * 1024 + col;
        const f32x4 s = *(const f32x4*)(src + o); if (!dry) *(f32x4*)(dst + o) = s + a;
    }
    DI void store8(int row, int col, f32x4 a, f32x4 b) const {
        const size_t o = (size_t)(row - rowoff) * 1024 + col;
        const f32x4 s0 = *(const f32x4*)(src + o), s1 = *(const f32x4*)(src + o + 4);
        if (!dry) { *(f32x4*)(dst + o) = s0 + a; *(f32x4*)(dst + o + 4) = s1 + b; }
    }
};
struct StGlr {
    float* glr;
    DI void operator()(int row, int col, f32x4 a) const { *(f32x4*)(glr + (size_t)row * 16 + col) = a; }
};

template <class St>
DI void mini_gemm(int wid0, const bf16_t* A, int lda, int arow0, int nrt, const bf16_t* Bt, int K, int N, const St& st) {
    const int tid_ = opaque_tid(wid0), lane = tid_ & 63, wave = tid_ >> 6, nw = opaque_gdim() * 8, nct = N / 16;
    const int gw = (wave * opaque_gdim() + opaque_bid());
    for (int t = gw; t < nrt * nct; t += nw) {
        const int rt = t % nrt, ct = t / nrt;
        const bf16_t* ap = A + (size_t)(arow0 + rt * 16 + (lane & 15)) * lda + 8 * (lane >> 4);
        const bf16_t* bp = Bt + (size_t)(ct * 16 + (lane & 15)) * K + 8 * (lane >> 4);
        f32x4 acc0 = (f32x4){0.f, 0.f, 0.f, 0.f}, acc1 = (f32x4){0.f, 0.f, 0.f, 0.f};
        for (int k0 = 0; k0 < K; k0 += 256) {
            bf16x8 a[8], b[8];
#pragma unroll
            for (int j = 0; j < 8; ++j) { a[j] = *(const bf16x8*)(ap + k0 + 32 * j); b[j] = *(const bf16x8*)(bp + k0 + 32 * j); }
#pragma unroll
            for (int j = 0; j < 8; j += 2) { acc0 = MFMA16(b[j], a[j], acc0); acc1 = MFMA16(b[j + 1], a[j + 1], acc1); }
        }
        st(arow0 + rt * 16 + (lane & 15), ct * 16 + 4 * (lane >> 4), acc0 + acc1);
    }
}
DI void glr_gemm(int wid0, const bf16_t* hn, const bf16_t* WgT, float* glr) {
    const int tid_ = opaque_tid(wid0), lane = tid_ & 63, wave = tid_ >> 6, nw = opaque_gdim() * 8;
    const int gw = ((7 - wave) * opaque_gdim() + opaque_bid());
    for (int t = gw; t < RCONT / 64; t += nw) {
        const bf16_t* ap = hn + (size_t)(t * 64 + (lane & 15)) * 1024 + 8 * (lane >> 4);
        const bf16_t* bp = WgT + (size_t)(lane & 15) * 1024 + 8 * (lane >> 4);
        f32x4 acc[4];
#pragma unroll
        for (int c = 0; c < 4; ++c) acc[c] = (f32x4){0.f, 0.f, 0.f, 0.f};
#pragma unroll 4
        for (int k0 = 0; k0 < 1024; k0 += 32) {
            const bf16x8 b = *(const bf16x8*)(bp + k0);
#pragma unroll
            for (int c = 0; c < 4; ++c) { const bf16x8 a = *(const bf16x8*)(ap + (size_t)c * 16 * 1024 + k0); acc[c] = MFMA16(b, a, acc[c]); }
        }
#pragma unroll
        for (int c = 0; c < 4; ++c) *(f32x4*)(glr + (size_t)(t * 64 + c * 16 + (lane & 15)) * 16 + 4 * (lane >> 4)) = acc[c];
    }
}

DI void phase_bias(int wid0, const Params& p) {
    float* T = (float*)(p.ws + WS_BIAS);
    const int i = opaque_bid() * 512 + opaque_tid(wid0);
    if (i < 8 * 129) {
        const int h = i / 129, n = i % 129; int bucket;
        if (n < 16) bucket = n;
        else { const float nf = (float)n; int lg = 16 + (int)(logf(nf / 16.f) / logf(8.f) * 16.f); bucket = lg < 31 ? lg : 31; }
        T[i] = p.rel_bias[bucket * 8 + h] * 1.4426950408889634f;
    }
}
DI void phase_norm(int wid0, const Params& p, int L) {
    const float* hreg = (L == 0) ? p.x : p.out; const float* hmeta = (L == 0) ? p.meta : (const float*)(p.ws + WS_HMETA);
    const float* g = p.g_norm + L * 1024; bf16_t* hn = (bf16_t*)(p.ws + WS_HN);
    const int tid_ = opaque_tid(wid0), wave = tid_ >> 6, lane = tid_ & 63, stride = opaque_gdim() * 8;
    f32x4 gv[4];
#pragma unroll
    for (int i = 0; i < 4; ++i) gv[i] = *(const f32x4*)(g + i * 256 + lane * 4);
    for (int row0 = opaque_bid() * 8 + wave; row0 < RCONT; row0 += 2 * stride) {
        f32x4 v[2][4]; float ss[2] = {0.f, 0.f};
#pragma unroll
        for (int q = 0; q < 2; ++q) {
            const int row = row0 + q * stride;
            if (row < MREG + 16) {
                const float* src = row < MREG ? hreg + (size_t)row * 1024 : hmeta + (size_t)(row - MREG) * 1024;
#pragma unroll
                for (int i = 0; i < 4; ++i) v[q][i] = *(const f32x4*)(src + i * 256 + lane * 4);
            } else {
#pragma unroll
                for (int i = 0; i < 4; ++i) v[q][i] = (f32x4){0.f, 0.f, 0.f, 0.f};
            }
        }
#pragma unroll
        for (int q = 0; q < 2; ++q) {
#pragma unroll
            for (int i = 0; i < 4; ++i) ss[q] += v[q][i][0] * v[q][i][0] + v[q][i][1] * v[q][i][1] + v[q][i][2] * v[q][i][2] + v[q][i][3] * v[q][i][3];
            ss[q] = wave_sum(ss[q]);
        }
#pragma unroll
        for (int q = 0; q < 2; ++q) {
            const int row = row0 + q * stride;
            if (row < RCONT) {
                const float rstd = rsqrtf(ss[q] * (1.f / 1024.f) + 1e-6f);
                bf16_t* dst = hn + (size_t)row * 1024;
#pragma unroll
                for (int i = 0; i < 4; ++i) {
                    u32x2 w; w.x = cvt_pk_bf16(v[q][i][0] * rstd * gv[i][0], v[q][i][1] * rstd * gv[i][1]); w.y = cvt_pk_bf16(v[q][i][2] * rstd * gv[i][2], v[q][i][3] * rstd * gv[i][3]);
                    *(u32x2*)(dst + i * 256 + lane * 4) = w;
                }
            }
        }
    }
}
DI void phase_final(int wid0, const Params& p) {
    const int tid_ = opaque_tid(wid0), wave = tid_ >> 6, lane = tid_ & 63;
    for (int row = opaque_bid() * 8 + wave; row < MREG; row += opaque_gdim() * 8) {
        float* src = p.out + (size_t)row * 1024;
        f32x4 v[4]; float ss = 0.f;
#pragma unroll
        for (int i = 0; i < 4; ++i) { v[i] = *(const f32x4*)(src + i * 256 + lane * 4); ss += v[i][0] * v[i][0] + v[i][1] * v[i][1] + v[i][2] * v[i][2] + v[i][3] * v[i][3]; }
        ss = wave_sum(ss);
        const float rstd = rsqrtf(ss * (1.f / 1024.f) + 1e-6f);
#pragma unroll
        for (int i = 0; i < 4; ++i) { const f32x4 gv = *(const f32x4*)(p.g_final + i * 256 + lane * 4); *(f32x4*)(src + i * 256 + lane * 4) = v[i] * rstd * gv; }
    }
}
DI void wconv_tile(const float* W, int ldw, int K, bf16_t* Bt, int k0, int n0, float* tile, int lane) {
#pragma unroll
    for (int i = 0; i < 16; ++i) {
        const int k = (lane >> 4) + 4 * i, n4 = (lane & 15) * 4;
        const f32x4 v = *(const f32x4*)(W + (size_t)(k0 + k) * ldw + n0 + n4);
        tile[k * 65 + n4] = v[0]; tile[k * 65 + n4 + 1] = v[1]; tile[k * 65 + n4 + 2] = v[2]; tile[k * 65 + n4 + 3] = v[3];
    }
    asm volatile("s_waitcnt lgkmcnt(0)" ::: "memory");
#pragma unroll
    for (int i = 0; i < 8; ++i) {
        const int n = (lane >> 3) + 8 * i, k8 = (lane & 7) * 8;
        float e[8];
#pragma unroll
        for (int j = 0; j < 8; ++j) e[j] = tile[(k8 + j) * 65 + n];
        u32x4 w; w.x = cvt_pk_bf16(e[0], e[1]); w.y = cvt_pk_bf16(e[2], e[3]); w.z = cvt_pk_bf16(e[4], e[5]); w.w = cvt_pk_bf16(e[6], e[7]);
        *(u32x4*)(Bt + (size_t)(n0 + n) * K + k0 + k8) = w;
    }
    asm volatile("s_waitcnt lgkmcnt(0)" ::: "memory");
}
DI void wconv_all(int wid0, const float* Win, int Nmain, int ldw, bf16_t* win, const float* Wout, bf16_t* wout, unsigned char* lds) {
    const int tid = opaque_tid(wid0), lane = tid & 63, wave = tid >> 6, nw = opaque_gdim() * 8;
    float* tile = (float*)(lds + wave * 16640);
    const int t1 = 16 * (Nmain / 64), ttot = t1 + 32 * 16;
    for (int t = wave * opaque_gdim() + opaque_bid(); t < ttot; t += nw) {
        if (t < t1) wconv_tile(Win, ldw, 1024, win, (t & 15) * 64, (t >> 4) * 64, tile, lane);
        else { const int u = t - t1; wconv_tile(Wout, 1024, 2048, wout, (u & 31) * 64, (u >> 5) * 64, tile, lane); }
    }
}
DI void phase_wconv(int wid0, const Params& p, int L, unsigned char* lds) {
    const int li = L >> 1;
    bf16_t* win = (bf16_t*)(p.ws + WS_WIN); bf16_t* wout = (bf16_t*)(p.ws + WS_WOUT); bf16_t* wg = (bf16_t*)(p.ws + WS_WG);
    if ((L & 1) == 0) {
        const float* W = p.gla_w_in + (size_t)li * 1024 * 6160;
        wconv_all(wid0, W, 6144, 6160, win, p.gla_w_out + (size_t)li * 2048 * 1024, wout, lds);
        for (int i = opaque_bid() * 512 + opaque_tid(wid0); i < 16 * 1024; i += opaque_gdim() * 512) { const int r = i >> 10, k = i & 1023; wg[i] = (bf16_t)(cvt_pk_bf16(W[(size_t)k * 6160 + 6144 + r], 0.f) & 0xffffu); }
    } else {
        wconv_all(wid0, p.diff_w_in + (size_t)li * 1024 * 8192, 8192, 8192, win, p.diff_w_out + (size_t)li * 2048 * 1024, wout, lds);
    }
}

DI void phase_prep(int wid0, const Params& p, int L, unsigned char* lds, bool dry) {
    const int gi = L >> 1, tid = opaque_tid(wid0), wave = tid >> 6, lane = tid & 63, r32 = lane & 31, hi = lane >> 5;
    const float* wgu = p.gla_wgu + (size_t)gi * 16 * 1024; const float* bg = p.gla_bg + (size_t)gi * 1024;
    bf16_t* act = (bf16_t*)(p.ws + WS_ACT); bf16_t* qb = act; bf16_t* kb = act + RALLOC * 1024;
    bf16_t* khT = (bf16_t*)(p.ws + WS_HN); bf16_t* attn = (bf16_t*)(p.ws + WS_ATTN); float* Eo = (float*)(p.ws + WS_E); const float* glr = (const float*)(p.ws + WS_GLR);
    float* bs = (float*)lds; float* tot = (float*)(lds + 65536); float* gl = (float*)(lds + 67584); bf16_t* qs = (bf16_t*)(lds + 71680); bf16_t* xs = (bf16_t*)(lds + 105472);
    for (int u = opaque_bid(); u < 513 * 4; u += opaque_gdim()) {
        const int g = u >> 2, hd = u & 3; const bool ismeta = (g == 512); const int row0 = ismeta ? MREG : g * 64;
        for (int i = tid; i < 1024; i += 512) gl[i] = glr[(size_t)row0 * 16 + i];
        bf16x8 qreg[4], kreg[4];
#pragma unroll
        for (int it = 0; it < 4; ++it) {
            const int gid = tid + 512 * it, i = gid >> 5, d8 = (gid & 31) * 8;
            const size_t goff = (size_t)(row0 + i) * 1024 + hd * 256 + d8;
            qreg[it] = *(const bf16x8*)(qb + goff); kreg[it] = *(const bf16x8*)(kb + goff);
        }
        __syncthreads();
        {
            const int d = tid & 255, ih = tid >> 8; float w[16];
#pragma unroll
            for (int r = 0; r < 16; ++r) w[r] = wgu[r * 1024 + hd * 256 + d];
            const float bgd = bg[hd * 256 + d]; float run = 0.f;
            for (int ii = 0; ii < 32; ++ii) {
                const int i = ih * 32 + ii; float x = bgd;
                const f32x4 g0 = *(const f32x4*)(gl + i * 16), g1 = *(const f32x4*)(gl + i * 16 + 4), g2 = *(const f32x4*)(gl + i * 16 + 8), g3 = *(const f32x4*)(gl + i * 16 + 12);
#pragma unroll
                for (int r = 0; r < 4; ++r) { x = fmaf(g0[r], w[r], x); x = fmaf(g1[r], w[4 + r], x); x = fmaf(g2[r], w[8 + r], x); x = fmaf(g3[r], w[12 + r], x); }
                float lgv = (fminf(x, 0.f) - __logf(1.f + __expf(-fabsf(x)))) * 0.0625f;
                if (ismeta && i >= 16) lgv = 0.f;
                run += lgv; bs[i * 256 + d] = run;
            }
            tot[ih * 256 + d] = run;
        }
        asm volatile("s_waitcnt vmcnt(0)" ::: "memory");
        __syncthreads();
#pragma unroll
        for (int it = 0; it < 4; ++it) {
            const int gid = tid + 512 * it, i = gid >> 5, d8 = (gid & 31) * 8;
            const bf16x8 qv = qreg[it]; const bf16x8 kv = kreg[it];
            float qt[8];
            const f32x4 bsv[2] = {*(const f32x4*)(bs + i * 256 + d8), *(const f32x4*)(bs + i * 256 + d8 + 4)};
            const f32x4 t0v[2] = {*(const f32x4*)(tot + d8), *(const f32x4*)(tot + d8 + 4)};
            const f32x4 t1v[2] = {*(const f32x4*)(tot + 256 + d8), *(const f32x4*)(tot + 256 + d8 + 4)};
#pragma unroll
            for (int e = 0; e < 8; ++e) {
                const float b = bsv[e >> 2][e & 3] + (i >= 32 ? t0v[e >> 2][e & 3] : 0.f); const float bl = t0v[e >> 2][e & 3] + t1v[e >> 2][e & 3];
                qt[e] = bf2f(qv[e]) * 0.0625f * __expf(b);
                const float kh = bf2f(kv[e]) * __expf(bl - b);
                xs[(d8 + e) * 64 + (i ^ (2 * ((d8 >> 3) & 31)))] = (bf16_t)(cvt_pk_bf16(kh, 0.f) & 0xffffu);
            }
            u32x4 w; w.x = cvt_pk_bf16(qt[0], qt[1]); w.y = cvt_pk_bf16(qt[2], qt[3]); w.z = cvt_pk_bf16(qt[4], qt[5]); w.w = cvt_pk_bf16(qt[6], qt[7]);
            {
                const int ob = (((i >> 4) * 8 + (d8 >> 5)) * 64 + ((d8 & 31) >> 3) * 16 + (i & 15)) * 16;
                *(u32x4*)(qb + (size_t)(row0 + (ob >> 9)) * 1024 + hd * 256 + ((ob & 511) >> 1)) = w;
            }
            *(u32x4*)(qs + i * 264 + d8) = w;
        }
        __syncthreads();
#pragma unroll
        for (int it = 0; it < 4; ++it) {
            const int gid = tid + 512 * it, d = gid >> 3, j8 = gid & 7, sw = (d >> 3) & 31;
            u32x4 w = *(const u32x4*)(xs + d * 64 + ((j8 ^ (sw >> 2)) * 8));
            if (sw & 1) w = (u32x4){w.y, w.x, w.w, w.z};
            if (sw & 2) w = (u32x4){w.z, w.w, w.x, w.y};
            *(u32x4*)(khT + (size_t)u * 16384 + ((((d >> 5) * 4 + (j8 >> 1)) * 64 + (j8 & 1) * 32 + (d & 31)) * 8)) = w;
        }
        if (tid < 256) Eo[(size_t)u * 256 + tid] = __expf(tot[tid] + tot[256 + tid]);
        __syncthreads();
#pragma unroll
        for (int it = 0; it < 4; ++it) {
            const int gid = tid + 512 * it, i = gid >> 5, d8 = (gid & 31) * 8; float kt[8];
            const f32x4 bsv[2] = {*(const f32x4*)(bs + i * 256 + d8), *(const f32x4*)(bs + i * 256 + d8 + 4)};
            const f32x4 t0v[2] = {*(const f32x4*)(tot + d8), *(const f32x4*)(tot + d8 + 4)};
#pragma unroll
            for (int e = 0; e < 8; ++e) { const float b = bsv[e >> 2][e & 3] + (i >= 32 ? t0v[e >> 2][e & 3] : 0.f); kt[e] = bf2f(kreg[it][e]) * __expf(-b); }
            u32x4 w; w.x = cvt_pk_bf16(kt[0], kt[1]); w.y = cvt_pk_bf16(kt[2], kt[3]); w.z = cvt_pk_bf16(kt[4], kt[5]); w.w = cvt_pk_bf16(kt[6], kt[7]);
            *(u32x4*)(xs + i * 264 + d8) = w;
        }
        __syncthreads();
        if (wave < 4) {
            const int ib = wave >> 1, jb = wave & 1; f32x16 acc;
#pragma unroll
            for (int i = 0; i < 16; ++i) acc[i] = 0.f;
            if (!(ib == 0 && jb == 1)) {
#pragma unroll
                for (int s = 0; s < 16; ++s) {
                    const bf16x8 a = *(const bf16x8*)(qs + (32 * ib + r32) * 264 + 16 * s + 8 * hi);
                    const bf16x8 b = *(const bf16x8*)(xs + (32 * jb + r32) * 264 + 16 * s + 8 * hi);
                    acc = MFMA32(a, b, acc);
                }
            }
#pragma unroll
            for (int i = 0; i < 16; ++i) {
                const int row = 32 * ib + crow(i, hi), col = 32 * jb + r32; const float v = (col <= row) ? acc[i] : 0.f;
                attn[(size_t)u * 4096 + ((((row >> 4) * 2 + (col >> 5)) * 64 + ((col & 31) >> 3) * 16 + (row & 15)) * 8) + (col & 7)] = (bf16_t)(cvt_pk_bf16(v, 0.f) & 0xffffu);
            }
        }
        __syncthreads();
    }
}

DI s16x4 tr_read0(unsigned addr) { s16x4 r; asm volatile("ds_read_b64_tr_b16 %0, %1" : "=&v"(r) : "v"(addr) : "memory"); return r; }
#define PK8(L, H) (bf16x8){L[0], L[1], L[2], L[3], H[0], H[1], H[2], H[3]}
DI void phase_scan(int wid0, const Params& p, unsigned char* lds, bool dry) {
    const int tid = opaque_tid(wid0), wave = __builtin_amdgcn_readfirstlane(tid >> 6), lane = tid & 63, r32 = lane & 31, hi = lane >> 5, l15 = lane & 15, l4 = lane >> 4;
    bf16_t* act = (bf16_t*)(p.ws + WS_ACT); const bf16_t* qb = act; bf16_t* vb = act + RALLOC * 2048;
    const bf16_t* khT = (const bf16_t*)(p.ws + WS_HN); const bf16_t* attn = (const bf16_t*)(p.ws + WS_ATTN); const float* Eo = (const float*)(p.ws + WS_E);
    bf16_t* ometa = (bf16_t*)(p.ws + WS_OMETA);
    bf16_t* sbt = (bf16_t*)lds; bf16_t* vs = (bf16_t*)(lds + 67584);
    const unsigned vs_base = (unsigned)(size_t)(LAS unsigned char*)(lds + 67584);
    for (int u = opaque_bid(); u < 256; u += opaque_gdim()) {
        const int xcd = u & 7, ix = u >> 3, bh = xcd * 4 + (ix >> 3), vsi = ix & 7, b = bh >> 2, hd = bh & 3, colv = hd * 512 + vsi * 64;
        f32x16 S0, S1;
#pragma unroll
        for (int i = 0; i < 16; ++i) { S0[i] = 0.f; S1[i] = 0.f; }
        for (int i = tid; i < 33792 / 16; i += 512) *(u32x4*)((unsigned char*)sbt + i * 16) = (u32x4){0u, 0u, 0u, 0u};
        const int vj = tid >> 3, vc8 = (tid & 7) * 8;
        u32x4 vnext = *(const u32x4*)(vb + (size_t)(MREG + vj) * 2048 + colv + vc8);
        for (int c = 0; c < 65; ++c) {
            const int g = (c == 0) ? 512 : b * 64 + (c - 1), row0 = (c == 0) ? MREG : g * 64, ug = g * 4 + hd, cur = c & 1;
            *(u32x4*)(vs + cur * 4608 + vj * 72 + vc8) = vnext;
            __syncthreads();
            if (c + 1 < 65) vnext = *(const u32x4*)(vb + (size_t)((b * 64 + c) * 64 + vj) * 2048 + colv + vc8);
            const int ib = wave >> 1, cb0 = 2 * (wave & 1), i = 16 * ib + l15;
            const unsigned vao = vs_base + (unsigned)(cur * 9216 + (8 * l4 + (l15 >> 2)) * 144 + 2 * (16 * cb0 + 4 * (l15 & 3)));
            const unsigned vau = vs_base + (unsigned)(cur * 9216 + (8 * hi + (l15 >> 2)) * 144 + 2 * (16 * ((lane >> 4) & 1) + 4 * (l15 & 3)));
            s16x4 ol[2][2], oh[2][2], ul0[4], uh0[4], ul1[4], uh1[4];
#pragma unroll
            for (int cc = 0; cc < 2; ++cc)
#pragma unroll
                for (int s = 0; s < 2; ++s) { ol[cc][s] = tr_read0(vao + cc * 32 + s * 32 * 144); oh[cc][s] = tr_read0(vao + cc * 32 + s * 32 * 144 + 4 * 144); }
#pragma unroll
            for (int s = 0; s < 2; ++s) {
                ul0[s] = tr_read0(vau + s * 16 * 144); uh0[s] = tr_read0(vau + s * 16 * 144 + 4 * 144);
                ul1[s] = tr_read0(vau + s * 16 * 144 + 64); uh1[s] = tr_read0(vau + s * 16 * 144 + 4 * 144 + 64);
            }
            {
                const bf16_t* ap = attn + (size_t)ug * 4096 + (ib * 2 * 64 + lane) * 8;
                bf16x8 at[2], aq[8];
#pragma unroll
                for (int s = 0; s < 2; ++s) at[s] = *(const bf16x8*)(ap + s * 512);
#pragma unroll
                for (int s = 0; s < 8; ++s) { const int ob = ((ib * 8 + s) * 64 + lane) * 16; aq[s] = *(const bf16x8*)(qb + (size_t)(row0 + (ob >> 9)) * 1024 + hd * 256 + ((ob & 511) >> 1)); }
                asm volatile("s_waitcnt lgkmcnt(8)" ::: "memory"); __builtin_amdgcn_sched_barrier(0);
                f32x4 oacc[2];
#pragma unroll
                for (int cc = 0; cc < 2; ++cc) {
                    const int cb = cb0 + cc; oacc[cc] = (f32x4){0.f, 0.f, 0.f, 0.f};
#pragma unroll
                    for (int s = 0; s < 2; ++s) oacc[cc] = MFMA16(PK8(ol[cc][s], oh[cc][s]), at[s], oacc[cc]);
                    const bf16_t* sp = sbt + cur * 16896 + (16 * cb + l15) * 264 + 8 * l4;
#pragma unroll
                    for (int s = 0; s < 8; ++s) { const bf16x8 bfr = *(const bf16x8*)(sp + 32 * s); oacc[cc] = MFMA16(bfr, aq[s], oacc[cc]); }
                }
#pragma unroll
                for (int s = 2; s < 4; ++s) {
                    ul0[s] = tr_read0(vau + s * 16 * 144); uh0[s] = tr_read0(vau + s * 16 * 144 + 4 * 144);
                    ul1[s] = tr_read0(vau + s * 16 * 144 + 64); uh1[s] = tr_read0(vau + s * 16 * 144 + 4 * 144 + 64);
                }
#pragma unroll
                for (int cc = 0; cc < 2; ++cc) {
                    const int col = colv + 16 * (cb0 + cc) + 4 * l4;
                    u32x2 w; w.x = cvt_pk_bf16(oacc[cc][0], oacc[cc][1]); w.y = cvt_pk_bf16(oacc[cc][2], oacc[cc][3]);
                    if (dry) {} else if (c > 0) *(u32x2*)(vb + (size_t)(row0 + i) * 2048 + col) = w;
                    else if (b == 0 && i < 16) *(u32x2*)(ometa + (size_t)i * 2048 + col) = w;
                }
            }
            {
                const bf16_t* kp = khT + (size_t)ug * 16384 + (wave * 4 * 64 + lane) * 8;
                bf16x8 kt[4];
#pragma unroll
                for (int s = 0; s < 4; ++s) kt[s] = *(const bf16x8*)(kp + s * 512);
                const float* ep = Eo + (size_t)ug * 256 + 32 * wave + 4 * hi;
#pragma unroll
                for (int g4 = 0; g4 < 4; ++g4) { const f32x4 ev = *(const f32x4*)(ep + 8 * g4);
#pragma unroll
                    for (int j = 0; j < 4; ++j) { S0[4 * g4 + j] *= ev[j]; S1[4 * g4 + j] *= ev[j]; } }
                asm volatile("s_waitcnt lgkmcnt(0)" ::: "memory"); __builtin_amdgcn_sched_barrier(0);
#pragma unroll
                for (int s = 0; s < 4; ++s) {
                    S0 = MFMA32(kt[s], PK8(ul0[s], uh0[s]), S0);
                    S1 = MFMA32(kt[s], PK8(ul1[s], uh1[s]), S1);
                }
                bf16_t* wp = sbt + (cur ^ 1) * 16896 + r32 * 264 + 32 * wave + 4 * hi;
#pragma unroll
                for (int g4 = 0; g4 < 4; ++g4) {
                    u32x2 w0; w0.x = cvt_pk_bf16(S0[4 * g4], S0[4 * g4 + 1]); w0.y = cvt_pk_bf16(S0[4 * g4 + 2], S0[4 * g4 + 3]);
                    u32x2 w1; w1.x = cvt_pk_bf16(S1[4 * g4], S1[4 * g4 + 1]); w1.y = cvt_pk_bf16(S1[4 * g4 + 2], S1[4 * g4 + 3]);
                    *(u32x2*)(wp + 8 * g4) = w0; *(u32x2*)(wp + 32 * 264 + 8 * g4) = w1;
                }
            }
        }
        __syncthreads();
    }
}

DI void phase_gate(int wid0, const Params& p, int L, bool dry) {
    const int tid_ = opaque_tid(wid0), lane = tid_ & 63, gw = opaque_bid() * 8 + (tid_ >> 6), nw = opaque_gdim() * 8;
    bf16_t* act = (bf16_t*)(p.ws + WS_ACT); const bf16_t* vb = act + RALLOC * 2048; bf16_t* zb = act + RALLOC * 4096; const bf16_t* ometa = (const bf16_t*)(p.ws + WS_OMETA);
    const float* gn = p.gla_gn + (size_t)(L >> 1) * 2048;
    for (int t = gw; t < (MREG + 16) * 4; t += nw) {
        const int row = t >> 2, hd = t & 3;
        const bf16_t* op = row < MREG ? vb + (size_t)row * 2048 + hd * 512 + lane * 8 : ometa + (size_t)(row - MREG) * 2048 + hd * 512 + lane * 8;
        bf16_t* zp = zb + (size_t)row * 2048 + hd * 512 + lane * 8;
        const bf16x8 ov = *(const bf16x8*)op; const bf16x8 zv = *(const bf16x8*)zp;
        float of[8], ss = 0.f;
#pragma unroll
        for (int e = 0; e < 8; ++e) { of[e] = bf2f(ov[e]); ss += of[e] * of[e]; }
        ss = wave_sum(ss);
        const float rstd = rsqrtf(ss * (1.f / 512.f) + 1e-6f);
        const f32x4 g0 = *(const f32x4*)(gn + hd * 512 + lane * 8), g1 = *(const f32x4*)(gn + hd * 512 + lane * 8 + 4);
        float y[8];
#pragma unroll
        for (int e = 0; e < 8; ++e) { const float z = bf2f(zv[e]); y[e] = z / (1.f + __expf(-z)) * of[e] * rstd * (e < 4 ? g0[e] : g1[e - 4]); }
        u32x4 w; w.x = cvt_pk_bf16(y[0], y[1]); w.y = cvt_pk_bf16(y[2], y[3]); w.z = cvt_pk_bf16(y[4], y[5]); w.w = cvt_pk_bf16(y[6], y[7]);
        if (!dry) *(u32x4*)zp = w;
    }
}

constexpr float ATT_C = 0.088388347648318440f * 1.4426950408889634f;
constexpr float ATT_THR2 = 8.f * 1.4426950408889634f;
#define KSWZ(row, colB) ((row) * 256 + ((colB) ^ (((row) & 7) << 4)))
DI int v_rd_base(int lane) { return ((lane & 3) << 3) | (((lane >> 2) & 3) << 6) | (((lane >> 4) & 1) << 5) | (((lane >> 5) & 1) << 8); }
constexpr int v_rd_off(int d0, int ks, int half) { return d0 * 512 + ks * 8192 + half * 4096; }
template <int OFF> DI s16x4 tr_read(int vb) { s16x4 r; asm volatile("ds_read_b64_tr_b16 %0, %1 offset:%2" : "=&v"(r) : "v"(vb), "i"(OFF) : "memory"); return r; }
template <int D0> DI void pv_two(f32x16& oa, f32x16& ob, int vb, bf16x8 pa0, bf16x8 pa1) {
    const s16x4 l0 = tr_read<v_rd_off(D0, 0, 0)>(vb), h0 = tr_read<v_rd_off(D0, 0, 1)>(vb), l1 = tr_read<v_rd_off(D0, 1, 0)>(vb), h1 = tr_read<v_rd_off(D0, 1, 1)>(vb);
    const s16x4 l2 = tr_read<v_rd_off(D0 + 1, 0, 0)>(vb), h2 = tr_read<v_rd_off(D0 + 1, 0, 1)>(vb), l3 = tr_read<v_rd_off(D0 + 1, 1, 0)>(vb), h3 = tr_read<v_rd_off(D0 + 1, 1, 1)>(vb);
    asm volatile("s_waitcnt lgkmcnt(0)" ::: "memory"); __builtin_amdgcn_sched_barrier(0);
    oa = MFMA32(pa0, PK8(l0, h0), oa);
    ob = MFMA32(pa0, PK8(l2, h2), ob);
    oa = MFMA32(pa1, PK8(l1, h1), oa);
    ob = MFMA32(pa1, PK8(l3, h3), ob);
    __builtin_amdgcn_sched_barrier(0);
}
DI void attn_stage(const bf16_t* kbase, const bf16_t* vbase, unsigned koff, unsigned voff, LAS unsigned char* ldsbuf, int wid) {
#pragma unroll
    for (int i = 0; i < 2; ++i) {
        const char* src = (const char*)kbase + (size_t)(i * 128) * 2;
        __builtin_amdgcn_global_load_lds((const unsigned*)(src + koff), (LAS unsigned*)(ldsbuf + (wid + 8 * i) * 1024), 16, 0, 0);
    }
#pragma unroll
    for (int i = 0; i < 2; ++i) {
        const char* src = (const char*)vbase + (size_t)(16 * i * 2048) * 2;
        __builtin_amdgcn_global_load_lds((const unsigned*)(src + voff), (LAS unsigned*)(ldsbuf + 16384 + (wid + 8 * i) * 1024), 16, 0, 0);
    }
}
DI void finalize_attn(const Params& p, unsigned char* lds, f32x16 (&o)[8], float l_reg, int lane_k, int wid, bool meta, int qrow0, int hh, int di, float lambda_init, bool dry) {
    int lane = (lane_k < 0) ? hw_lane() : lane_k; asm volatile("" : "+v"(lane));
    const int r32 = lane & 31, hi = lane >> 5, rg = wid & 3, psub = wid >> 2;
    float* wsx = (float*)(lds + 132096) + wid * 64; float* li_l = wsx; const float* misc = (const float*)(lds + 134144);
    float* X = (float*)lds; bf16_t* qbuf = (bf16_t*)(p.ws + WS_ACT);
    if (hi == 0) li_l[r32] = l_reg;
    asm volatile("s_waitcnt lgkmcnt(0)" ::: "memory");
    {
        const float sc = psub ? -misc[0] : 1.f;
#pragma unroll
        for (int r = 0; r < 16; ++r) {
            const float c = sc / li_l[crow(r, hi)];
#pragma unroll
            for (int d = 0; d < 8; ++d) o[d][r] *= c;
        }
    }
    __syncthreads();
    if (psub == 1) {
#pragma unroll
        for (int d = 0; d < 8; ++d)
#pragma unroll
            for (int r = 0; r < 16; ++r) X[(rg * 128 + d * 16 + r) * 64 + lane] = o[d][r];
    }
    __syncthreads();
    if (psub == 0) {
#pragma unroll
        for (int d = 0; d < 8; ++d)
#pragma unroll
            for (int r = 0; r < 16; ++r) o[d][r] += X[(rg * 128 + d * 16 + r) * 64 + lane];
        asm volatile("s_waitcnt lgkmcnt(0)" ::: "memory");
        float* R = (float*)(lds + rg * 32768);
#pragma unroll
        for (int d = 0; d < 8; ++d)
#pragma unroll
            for (int r = 0; r < 16; ++r) R[crow(r, hi) * 256 + 32 * d + r32] = o[d][r];
        asm volatile("s_waitcnt lgkmcnt(0)" ::: "memory");
        const float og = 1.f - misc[1]; const int c8 = (lane & 31) * 8;
        const f32x4 g0 = *(const f32x4*)(p.diff_gn + (size_t)di * 256 + c8) * og, g1 = *(const f32x4*)(p.diff_gn + (size_t)di * 256 + c8 + 4) * og;
        bf16_t* dstb = qbuf + (size_t)(qrow0 + 32 * rg + (lane >> 5)) * 2048 + hh * 256 + c8;
        const int nrow = dry ? 0 : (meta ? (rg == 0 ? 16 : 0) : 32);
#pragma unroll 2
        for (int it = 0; it < 16; ++it) {
            const int row = 2 * it + (lane >> 5);
            f32x4 a = *(const f32x4*)(R + row * 256 + c8), b = *(const f32x4*)(R + row * 256 + c8 + 4);
            float ss = a[0] * a[0] + a[1] * a[1] + a[2] * a[2] + a[3] * a[3] + b[0] * b[0] + b[1] * b[1] + b[2] * b[2] + b[3] * b[3];
            ss = half_sum(ss);
            const float rstd = rsqrtf(ss * (1.f / 256.f) + 1e-6f);
            a = a * rstd * g0; b = b * rstd * g1;
            u32x4 w; w.x = cvt_pk_bf16(a[0], a[1]); w.y = cvt_pk_bf16(a[2], a[3]); w.z = cvt_pk_bf16(b[0], b[1]); w.w = cvt_pk_bf16(b[2], b[3]);
            if (row < nrow) *(u32x4*)(dstb + (size_t)it * 4096) = w;
        }
    }
}
DI void phase_attn(int wid0, const Params& p, int L, unsigned char* lds, bool dry) {
    const int di = L >> 1; const float lambda_init = 0.8f - 0.6f * __expf(-0.3f * (float)L);
    const int tid = opaque_tid(wid0), wid = __builtin_amdgcn_readfirstlane(tid >> 6), lane_k = tid & 63, rg = wid & 3, psub = wid >> 2;
    LAS unsigned char* ldsl = (LAS unsigned char*)lds;
    float* tab = (float*)(lds + 131072); float* wsx = (float*)(lds + 132096) + wid * 64; float* li_l = wsx; float* al_l = wsx + 32; float* misc = (float*)(lds + 134144);
    float* X = (float*)lds;
    bf16_t* act = (bf16_t*)(p.ws + WS_ACT); bf16_t* qbuf = act; const bf16_t* kbuf = act + RALLOC * 2048; const bf16_t* vbuf = act + RALLOC * 4096;
    const float* biasT = (const float*)(p.ws + WS_BIAS);
    if (wid == 0) {
        const float* lv = p.diff_lam + (size_t)di * 512;
        const int lane = lane_k; float s1 = lv[lane] * lv[128 + lane] + lv[64 + lane] * lv[192 + lane], s2 = lv[256 + lane] * lv[384 + lane] + lv[320 + lane] * lv[448 + lane];
        s1 = wave_sum(s1); s2 = wave_sum(s2);
        if (lane == 0) { misc[0] = __expf(s1) - __expf(s2) + lambda_init; misc[1] = lambda_init; }
    }
    __syncthreads();
    const int G = opaque_gdim(), blk = opaque_bid();
    for (int ui = 0;; ++ui) {
        int b, hh, qb; bool meta = false;
        int lane = lane_k; asm volatile("" : "+v"(lane));
        const int r32 = lane & 31, hi = lane >> 5;
        unsigned koff, voff;
        { const int row = 4 * wid + (lane >> 4), gsrc = (lane & 15) ^ (row & 7); koff = (unsigned)(row * 2048 + 8 * gsrc) * 2u;
          const int w5 = (lane & 31) >> 2, kl = (w5 & 3) + 8 * (w5 >> 2) + 4 * (wid >> 2), col = ((2 * wid + (lane >> 5)) & 7) * 32 + (lane & 3) * 8; voff = (unsigned)(kl * 2048 + col) * 2u; }

        if (G == 256) {
            if (ui < 8) { const int bh = 8 * ui + (blk & 7), j = blk >> 3; qb = (ui & 1) ? 31 - j : j; b = bh >> 3; hh = bh & 7; }
            else if (ui == 8 && blk < 8) { meta = true; hh = blk; b = 0; qb = 0; }
            else break;
        } else {
            const int u = blk + ui * G;
            if (u < 2048) { const int bh = u & 63; qb = 31 - (u >> 6); b = bh >> 3; hh = bh & 7; }
            else if (u < 2056) { meta = true; hh = u - 2048; b = 0; qb = 0; }
            else break;
        }
        const int qrow0 = meta ? MREG : b * 4096 + 128 * qb, qpos0 = meta ? 0 : 16 + 128 * qb, ntiles = meta ? 1 : 1 + 4 * (qb + 1);
        if (tid < 130) tab[tid] = (tid < 129) ? biasT[hh * 129 + tid] : -__builtin_inff();
        int myrow = qrow0 + 32 * rg + r32; if (meta && myrow > MREG + 63) myrow = MREG + 63;
        const bf16_t* qp = qbuf + (size_t)myrow * 2048 + hh * 256 + psub * 128 + hi * 8;
        unsigned char* qlds = lds + wid * 8192 + lane * 16;
#pragma unroll
        for (int d0 = 0; d0 < 8; ++d0) *(bf16x8*)(qlds + d0 * 1024) = *(const bf16x8*)(qp + d0 * 16);
        const int wq0 = qpos0 + 32 * rg, qpos = wq0 + r32;
        const bf16_t* kh_ = kbuf + hh * 256; const bf16_t* vh_ = vbuf + hh * 256;
        attn_stage(kh_ + (size_t)MREG * 2048, vh_ + (size_t)MREG * 2048, koff, voff, ldsl + 65536, wid);
        f32x16 o[8];
#pragma unroll
        for (int d = 0; d < 8; ++d)
#pragma unroll
            for (int r = 0; r < 16; ++r) o[d][r] = 0.f;
        float m_reg = -1e30f, l_reg = 0.f;
        for (int t = 0; t < ntiles; ++t) {
            asm volatile("s_waitcnt vmcnt(0) lgkmcnt(0)" ::: "memory"); __builtin_amdgcn_s_barrier(); asm volatile("" ::: "memory");
            if (t + 1 < ntiles) attn_stage(kh_ + (size_t)(b * 4096 + 32 * t) * 2048, vh_ + (size_t)(b * 4096 + 32 * t) * 2048, koff, voff, ldsl + 65536 + ((t + 1) & 1) * 32768, wid);
            const int kpos0 = (t == 0) ? 0 : 16 + 32 * (t - 1);
            if (kpos0 <= wq0 + 31) {
                const unsigned char* Ks = lds + 65536 + (t & 1) * 32768 + psub * 8192;
                f32x16 p0, p0b;
#pragma unroll
                for (int r = 0; r < 16; ++r) { p0[r] = 0.f; p0b[r] = 0.f; }
                int swz = (r32 & 6) << 4, kro = r32 * 256 + ((hi ^ (r32 & 1)) << 4); asm volatile("" : "+v"(swz), "+v"(kro));
#pragma unroll
                for (int d0 = 0; d0 < 8; d0 += 2) {
                    const bf16x8 b0 = *(const bf16x8*)(Ks + kro + ((d0 * 32) ^ swz));
                    const bf16x8 qf = *(const bf16x8*)(qlds + d0 * 1024);
                    const bf16x8 b1 = *(const bf16x8*)(Ks + kro + (((d0 + 1) * 32) ^ swz));
                    const bf16x8 qg = *(const bf16x8*)(qlds + (d0 + 1) * 1024);
                    p0 = MFMA32(b0, qf, p0);
                    p0b = MFMA32(b1, qg, p0b);
                    if (d0 == 2) __builtin_amdgcn_sched_barrier(0);
                }
#pragma unroll
                for (int r = 0; r < 16; ++r) p0[r] += p0b[r];
                __builtin_amdgcn_sched_barrier(0);
                if (t > 0 && wq0 - (kpos0 + 31) >= 128) {
                    const float bfar = tab[128];
#pragma unroll
                    for (int r = 0; r < 16; ++r) p0[r] = fmaf(p0[r], ATT_C, bfar);
                } else {
#pragma unroll
                    for (int r = 0; r < 16; ++r) {
                        const int k0i = crow(r, hi);
                        const int d0v = qpos - (kpos0 + k0i);
                        const bool v0 = (d0v >= 0) && (t > 0 || k0i < 16);
                        const int idx = v0 ? (d0v < 128 ? d0v : 128) : 129;
                        p0[r] = fmaf(p0[r], ATT_C, tab[idx]);
                        if ((r & 3) == 3) __builtin_amdgcn_sched_barrier(0);
                    }
                }
                __builtin_amdgcn_sched_barrier(0);
                float pmax = p0[0];
#pragma unroll
                for (int r = 1; r < 16; ++r) pmax = fmaxf(pmax, p0[r]);
                { auto rr = __builtin_amdgcn_permlane32_swap(__float_as_uint(pmax), __float_as_uint(pmax), false, false); pmax = fmaxf(__uint_as_float(rr[0]), __uint_as_float(rr[1])); }
                float mn, alpha;
                if (__all(pmax - m_reg <= ATT_THR2)) { mn = m_reg; alpha = 1.f; }
                else { mn = fmaxf(m_reg, pmax); alpha = __builtin_amdgcn_exp2f(m_reg - mn); m_reg = mn; }
                float ps = 0.f;
#pragma unroll
                for (int r = 0; r < 16; ++r) { p0[r] = __builtin_amdgcn_exp2f(p0[r] - mn); ps += p0[r]; }
                { auto rr = __builtin_amdgcn_permlane32_swap(__float_as_uint(ps), __float_as_uint(ps), false, false); ps = __uint_as_float(rr[0]) + __uint_as_float(rr[1]); }
                l_reg = l_reg * alpha + ps;
                __builtin_amdgcn_sched_barrier(0);
                bf16x8 pa0, pa1;
#define PK4(P, BASE, OUT) do { unsigned a0 = cvt_pk_bf16(P[BASE + 0], P[BASE + 1]), a1 = cvt_pk_bf16(P[BASE + 2], P[BASE + 3]);   \
    unsigned b0_ = cvt_pk_bf16(P[BASE + 4], P[BASE + 5]), b1_ = cvt_pk_bf16(P[BASE + 6], P[BASE + 7]);                              \
    auto r0 = __builtin_amdgcn_permlane32_swap(a0, b0_, false, false); auto r1 = __builtin_amdgcn_permlane32_swap(a1, b1_, false, false); \
    u32x4 w_ = {r0[0], r1[0], r0[1], r1[1]}; OUT = __builtin_bit_cast(bf16x8, w_); } while (0)
                PK4(p0, 0, pa0); PK4(p0, 8, pa1);
#undef PK4
                __builtin_amdgcn_sched_barrier(0);
                if (__any(alpha < 1.f)) {
                    if (hi == 0) al_l[r32] = alpha;
                    asm volatile("s_waitcnt lgkmcnt(0)" ::: "memory");
                    float ar[16];
#pragma unroll
                    for (int r = 0; r < 16; ++r) ar[r] = al_l[crow(r, hi)];
#pragma unroll
                    for (int d = 0; d < 8; ++d)
#pragma unroll
                        for (int r = 0; r < 16; ++r) o[d][r] *= ar[r];
                }
                __builtin_amdgcn_sched_barrier(0);
                const int vb0 = (int)(unsigned)(size_t)(ldsl + 65536 + (t & 1) * 32768 + 16384) + v_rd_base(lane);
                __builtin_amdgcn_s_setprio(1);
#define PV_RD(D0, L0, H0, L1, H1) L0 = tr_read<v_rd_off(D0, 0, 0)>(vb0); H0 = tr_read<v_rd_off(D0, 0, 1)>(vb0); L1 = tr_read<v_rd_off(D0, 1, 0)>(vb0); H1 = tr_read<v_rd_off(D0, 1, 1)>(vb0)
#define PV_MM(D0, L0, H0, L1, H1) o[D0] = MFMA32(pa0, PK8(L0, H0), o[D0]); o[D0] = MFMA32(pa1, PK8(L1, H1), o[D0])
#define PV_W4() asm volatile("s_waitcnt lgkmcnt(4)" ::: "memory"); __builtin_amdgcn_sched_barrier(0)
                {
                    s16x4 a0, a1, a2, a3, b0_, b1_, b2_, b3_;
                    PV_RD(0, a0, a1, a2, a3);
                    PV_RD(1, b0_, b1_, b2_, b3_); PV_W4(); PV_MM(0, a0, a1, a2, a3); __builtin_amdgcn_sched_barrier(0);
                    PV_RD(2, a0, a1, a2, a3); PV_W4(); PV_MM(1, b0_, b1_, b2_, b3_); __builtin_amdgcn_sched_barrier(0);
                    PV_RD(3, b0_, b1_, b2_, b3_); PV_W4(); PV_MM(2, a0, a1, a2, a3); __builtin_amdgcn_sched_barrier(0);
                    PV_RD(4, a0, a1, a2, a3); PV_W4(); PV_MM(3, b0_, b1_, b2_, b3_); __builtin_amdgcn_sched_barrier(0);
                    PV_RD(5, b0_, b1_, b2_, b3_); PV_W4(); PV_MM(4, a0, a1, a2, a3); __builtin_amdgcn_sched_barrier(0);
                    PV_RD(6, a0, a1, a2, a3); PV_W4(); PV_MM(5, b0_, b1_, b2_, b3_); __builtin_amdgcn_sched_barrier(0);
                    PV_RD(7, b0_, b1_, b2_, b3_); PV_W4(); PV_MM(6, a0, a1, a2, a3); __builtin_amdgcn_sched_barrier(0);
                    asm volatile("s_waitcnt lgkmcnt(0)" ::: "memory"); __builtin_amdgcn_sched_barrier(0); PV_MM(7, b0_, b1_, b2_, b3_); __builtin_amdgcn_sched_barrier(0);
                }
#undef PV_RD
#undef PV_MM
#undef PV_W4
                __builtin_amdgcn_s_setprio(0);
            }
        }
        finalize_attn(p, lds, o, l_reg, lane_k, wid, meta, qrow0, hh, di, lambda_init, dry);
        __syncthreads();
    }
}


DI void attn_stage64(const bf16_t* kbase, const bf16_t* vbase, unsigned koff, unsigned voff, LAS unsigned char* ldsbuf, int wid) {
#pragma unroll
    for (int i = 0; i < 4; ++i) {
        const unsigned off = koff + (unsigned)((32 * (i & 1)) * 2048 + (i >> 1) * 128) * 2u;
        __builtin_amdgcn_global_load_lds((const unsigned*)((const char*)kbase + off), (LAS unsigned*)(ldsbuf + (wid + 8 * i) * 1024), 16, 0, 0);
    }
#pragma unroll
    for (int i = 0; i < 4; ++i) {
        const unsigned off = voff + (unsigned)(16 * i * 2048) * 2u;
        __builtin_amdgcn_global_load_lds((const unsigned*)((const char*)vbase + off), (LAS unsigned*)(ldsbuf + 32768 + (wid + 8 * i) * 1024), 16, 0, 0);
    }
}
template <int D0, int KH> DI void pv_two64(f32x16& oa, f32x16& ob, int vb, bf16x8 pa0, bf16x8 pa1) {
    const s16x4 l0 = tr_read<v_rd_off(D0, 2 * KH, 0)>(vb), h0 = tr_read<v_rd_off(D0, 2 * KH, 1)>(vb), l1 = tr_read<v_rd_off(D0, 2 * KH + 1, 0)>(vb), h1 = tr_read<v_rd_off(D0, 2 * KH + 1, 1)>(vb);
    const s16x4 l2 = tr_read<v_rd_off(D0 + 1, 2 * KH, 0)>(vb), h2 = tr_read<v_rd_off(D0 + 1, 2 * KH, 1)>(vb), l3 = tr_read<v_rd_off(D0 + 1, 2 * KH + 1, 0)>(vb), h3 = tr_read<v_rd_off(D0 + 1, 2 * KH + 1, 1)>(vb);
    asm volatile("s_waitcnt lgkmcnt(0)" ::: "memory"); __builtin_amdgcn_sched_barrier(0);
    oa = MFMA32(pa0, PK8(l0, h0), oa);
    ob = MFMA32(pa0, PK8(l2, h2), ob);
    oa = MFMA32(pa1, PK8(l1, h1), oa);
    ob = MFMA32(pa1, PK8(l3, h3), ob);
    __builtin_amdgcn_sched_barrier(0);
}
template <int KH> DI void attn_half(f32x16 (&o)[8], const bf16x8 (&qr)[8], float& m_reg, float& l_reg, const unsigned char* Ks, int vb0, const float* tab, float* al_l,
                                    int r32, int hi, int qpos, int wq0, int kpos0, bool t0) {
    if (kpos0 > wq0 + 31) return;
    f32x16 p0;
#pragma unroll
    for (int r = 0; r < 16; ++r) p0[r] = 0.f;
    int swz = (r32 & 6) << 4, kro = (32 * KH + r32) * 256 + ((hi ^ (r32 & 1)) << 4); asm volatile("" : "+v"(swz), "+v"(kro));
#pragma unroll
    for (int d0 = 0; d0 < 8; ++d0) {
        const bf16x8 b0 = *(const bf16x8*)(Ks + kro + ((d0 * 32) ^ swz));
        p0 = MFMA32(b0, qr[d0], p0);
        if (d0 == 3) __builtin_amdgcn_sched_barrier(0);
    }
    __builtin_amdgcn_sched_barrier(0);
    if (!t0 && wq0 - (kpos0 + 31) >= 128) {
        const float bfar = tab[128];
#pragma unroll
        for (int r = 0; r < 16; ++r) p0[r] = fmaf(p0[r], ATT_C, bfar);
    } else {
#pragma unroll
        for (int r = 0; r < 16; ++r) {
            const int k0i = crow(r, hi);
            const int d0v = qpos - (kpos0 + k0i);
            const bool v0 = (d0v >= 0) && (!t0 || k0i < 16);
            const int idx = v0 ? (d0v < 128 ? d0v : 128) : 129;
            p0[r] = fmaf(p0[r], ATT_C, tab[idx]);
            if ((r & 3) == 3) __builtin_amdgcn_sched_barrier(0);
        }
    }
    __builtin_amdgcn_sched_barrier(0);
    float pmax = p0[0];
#pragma unroll
    for (int r = 1; r < 16; ++r) pmax = fmaxf(pmax, p0[r]);
    { auto rr = __builtin_amdgcn_permlane32_swap(__float_as_uint(pmax), __float_as_uint(pmax), false, false); pmax = fmaxf(__uint_as_float(rr[0]), __uint_as_float(rr[1])); }
    float mn, alpha;
    if (__all(pmax - m_reg <= ATT_THR2)) { mn = m_reg; alpha = 1.f; }
    else { mn = fmaxf(m_reg, pmax); alpha = __builtin_amdgcn_exp2f(m_reg - mn); m_reg = mn; }
    float ps = 0.f;
#pragma unroll
    for (int r = 0; r < 16; ++r) { p0[r] = __builtin_amdgcn_exp2f(p0[r] - mn); ps += p0[r]; }
    { auto rr = __builtin_amdgcn_permlane32_swap(__float_as_uint(ps), __float_as_uint(ps), false, false); ps = __uint_as_float(rr[0]) + __uint_as_float(rr[1]); }
    l_reg = l_reg * alpha + ps;
    __builtin_amdgcn_sched_barrier(0);
    bf16x8 pa0, pa1;
#define PK4(P, BASE, OUT) do { unsigned a0 = cvt_pk_bf16(P[BASE + 0], P[BASE + 1]), a1 = cvt_pk_bf16(P[BASE + 2], P[BASE + 3]);   \
    unsigned b0_ = cvt_pk_bf16(P[BASE + 4], P[BASE + 5]), b1_ = cvt_pk_bf16(P[BASE + 6], P[BASE + 7]);                              \
    auto r0 = __builtin_amdgcn_permlane32_swap(a0, b0_, false, false); auto r1 = __builtin_amdgcn_permlane32_swap(a1, b1_, false, false); \
    u32x4 w_ = {r0[0], r1[0], r0[1], r1[1]}; OUT = __builtin_bit_cast(bf16x8, w_); } while (0)
    PK4(p0, 0, pa0); PK4(p0, 8, pa1);
#undef PK4
    __builtin_amdgcn_sched_barrier(0);
    if (__any(alpha < 1.f)) {
        if (hi == 0) al_l[r32] = alpha;
        asm volatile("s_waitcnt lgkmcnt(0)" ::: "memory");
        float ar[16];
#pragma unroll
        for (int r = 0; r < 16; ++r) ar[r] = al_l[crow(r, hi)];
#pragma unroll
        for (int d = 0; d < 8; ++d)
#pragma unroll
            for (int r = 0; r < 16; ++r) o[d][r] *= ar[r];
    }
    __builtin_amdgcn_sched_barrier(0);
    pv_two64<0, KH>(o[0], o[1], vb0, pa0, pa1); pv_two64<2, KH>(o[2], o[3], vb0, pa0, pa1); pv_two64<4, KH>(o[4], o[5], vb0, pa0, pa1); pv_two64<6, KH>(o[6], o[7], vb0, pa0, pa1);
}
DI void phase_attn64(int wid0, const Params& p, int L, unsigned char* lds, bool dry) {
    const int di = L >> 1; const float lambda_init = 0.8f - 0.6f * __expf(-0.3f * (float)L);
    const int tid = opaque_tid(wid0), wid = __builtin_amdgcn_readfirstlane(tid >> 6), lane_k = tid & 63, rg = wid & 3, psub = wid >> 2;
    LAS unsigned char* ldsl = (LAS unsigned char*)lds;
    float* tab = (float*)(lds + 131072); float* wsx = (float*)(lds + 132096) + wid * 64; float* al_l = wsx + 32; float* misc = (float*)(lds + 134144);
    bf16_t* act = (bf16_t*)(p.ws + WS_ACT); bf16_t* qbuf = act; const bf16_t* kbuf = act + RALLOC * 2048; const bf16_t* vbuf = act + RALLOC * 4096;
    const float* biasT = (const float*)(p.ws + WS_BIAS);
    if (wid == 0) {
        const float* lv = p.diff_lam + (size_t)di * 512;
        const int lane = lane_k; float s1 = lv[lane] * lv[128 + lane] + lv[64 + lane] * lv[192 + lane], s2 = lv[256 + lane] * lv[384 + lane] + lv[320 + lane] * lv[448 + lane];
        s1 = wave_sum(s1); s2 = wave_sum(s2);
        if (lane == 0) { misc[0] = __expf(s1) - __expf(s2) + lambda_init; misc[1] = lambda_init; }
    }
    __syncthreads();
    const int blk = opaque_bid();
    for (int ui = 0;; ++ui) {
        int b, hh, qb; bool meta = false;
        int lane = hw_lane(); asm volatile("" : "+v"(lane));
        const int r32 = lane & 31, hi = lane >> 5;
#define ATT_OFFS(LN) unsigned koff, voff; { int ln_ = (LN); asm volatile("" : "+v"(ln_)); const int row = 4 * wid + (ln_ >> 4), gsrc = (ln_ & 15) ^ (row & 7); koff = (unsigned)(row * 2048 + 8 * gsrc) * 2u; \
          const int w5 = (ln_ & 31) >> 2, kl = (w5 & 3) + 8 * (w5 >> 2) + 4 * (wid >> 2), col = ((2 * wid + (ln_ >> 5)) & 7) * 32 + (ln_ & 3) * 8; voff = (unsigned)(kl * 2048 + col) * 2u; }
        if (ui < 8) { const int bh = 8 * ui + (blk & 7), j = (blk >> 3) & 31; qb = (ui & 1) ? 31 - j : j; b = bh >> 3; hh = bh & 7; }
        else if (ui == 8 && blk < 8) { meta = true; hh = blk; b = 0; qb = 0; }
        else break;
        const int qrow0 = meta ? MREG : b * 4096 + 128 * qb, qpos0 = meta ? 0 : 16 + 128 * qb, ntiles = meta ? 1 : 1 + 2 * (qb + 1);
        { const int t_ = wid * 64 + lane; if (t_ < 130) tab[t_] = (t_ < 129) ? biasT[hh * 129 + t_] : -__builtin_inff(); }
        __builtin_amdgcn_sched_barrier(0);
        int myrow = qrow0 + 32 * rg + r32; if (meta && myrow > MREG + 63) myrow = MREG + 63;
        const bf16_t* qp = qbuf + (size_t)myrow * 2048 + hh * 256 + psub * 128 + hi * 8;
        bf16x8 qr[8];
#pragma unroll
        for (int d0 = 0; d0 < 8; ++d0) qr[d0] = *(const bf16x8*)(qp + d0 * 16);
        __builtin_amdgcn_sched_barrier(0);
        const int wq0 = qpos0 + 32 * rg, qpos = wq0 + r32;
        const bf16_t* kh_ = kbuf + hh * 256; const bf16_t* vh_ = vbuf + hh * 256;
        { ATT_OFFS(lane); attn_stage64(kh_ + (size_t)MREG * 2048, vh_ + (size_t)MREG * 2048, koff, voff, ldsl, wid); }
        __builtin_amdgcn_sched_barrier(0);
        f32x16 o[8];
#pragma unroll
        for (int d = 0; d < 8; ++d)
#pragma unroll
            for (int r = 0; r < 16; ++r) o[d][r] = 0.f;
        float m_reg = -1e30f, l_reg = 0.f;
        for (int t = 0; t < ntiles; ++t) {
            asm volatile("s_waitcnt vmcnt(0) lgkmcnt(0)" ::: "memory"); __builtin_amdgcn_s_barrier(); asm volatile("" ::: "memory");
            if (t + 1 < ntiles) { ATT_OFFS(lane); attn_stage64(kh_ + (size_t)(b * 4096 + 64 * t) * 2048, vh_ + (size_t)(b * 4096 + 64 * t) * 2048, koff, voff, ldsl + ((t + 1) & 1) * 65536, wid); }
            const int kpos0 = (t == 0) ? 0 : 16 + 64 * (t - 1);
            const unsigned char* Ks = lds + (t & 1) * 65536 + psub * 16384;
            const int vb0 = (int)(unsigned)(size_t)(ldsl + (t & 1) * 65536 + 32768) + v_rd_base(lane);
            attn_half<0>(o, qr, m_reg, l_reg, Ks, vb0, tab, al_l, r32, hi, qpos, wq0, kpos0, t == 0);
            if (t > 0) attn_half<1>(o, qr, m_reg, l_reg, Ks, vb0, tab, al_l, r32, hi, qpos, wq0, kpos0 + 32, false);
        }
        finalize_attn(p, lds, o, l_reg, -1, wid, meta, qrow0, hh, di, lambda_init, dry);
        __syncthreads();
    }
}

#define XB_TMO      128
#define XB_XCNT(j)  (256  + 64 * (j))
#define XB_XSUB(j)  (1280 + 64 * (j))
#define XB_XGEN(j)  (2304 + 64 * (j))
#define XB_TOP      3328
#define XB_TOPGEN   3392
#define XCD_BAR_WORDS 3456
#define XB_SPIN_CAP (1u << 22)
DI unsigned xb_ld(unsigned* p)              { return __hip_atomic_load(p, __ATOMIC_RELAXED, __HIP_MEMORY_SCOPE_AGENT); }
DI unsigned xb_add(unsigned* p, unsigned v) { return __hip_atomic_fetch_add(p, v, __ATOMIC_RELAXED, __HIP_MEMORY_SCOPE_AGENT); }
DI unsigned xb_xcc_id() { return (unsigned)__builtin_amdgcn_s_getreg((3 << 11) | 20) & 0xFu; }
#define XB_SPIN(cond, bar) do { unsigned _sp = 0; while (cond) { __builtin_amdgcn_s_sleep(1); \
    if ((++_sp & 255u) == 0u) { if (xb_ld(&(bar)[XB_TMO])) break; if (_sp > XB_SPIN_CAP) { atomicAdd(&(bar)[XB_TMO], 1u); break; } } } } while (0)
struct XcdBarrier { unsigned* bar; unsigned x; volatile LAS unsigned* st; };
DI XcdBarrier xcd_barrier_post(int wid0, unsigned* bar, volatile LAS unsigned* st) {
    XcdBarrier b; b.bar = bar; b.x = xb_xcc_id(); b.st = st;
    if (wid0 == 0 && hw_lane() == 0) (void)xb_add(&bar[XB_XCNT(b.x)], 1u);
    return b;
}
DI void xcd_barrier_complete(unsigned* bar, unsigned x, unsigned& nloc, unsigned& nx) {
    const unsigned G = (unsigned)opaque_gdim();
    unsigned sum, cnt, mine, sp = 0u;
    for (;;) {
        sum = 0u; cnt = 0u; mine = 0u;
#pragma unroll
        for (unsigned j = 0; j < 16; ++j) { const unsigned c = xb_ld(&bar[XB_XCNT(j)]); sum += c; cnt += (c > 0u) ? 1u : 0u; mine = (j == x) ? c : mine; }
        if (sum == G) break;
        __builtin_amdgcn_s_sleep(1);
        if ((++sp & 255u) == 0u) { if (xb_ld(&bar[XB_TMO])) break; if (sp > XB_SPIN_CAP) { atomicAdd(&bar[XB_TMO], 1u); break; } }
    }
    nloc = mine > 0u ? mine : 1u; nx = cnt > 0u ? cnt : 1u;
}
DI void xcd_barrier(int wid0, const XcdBarrier& b) {
    asm volatile("s_waitcnt vmcnt(0)" ::: "memory");
    __syncthreads();
    if (wid0 == 0 && hw_lane() == 0) {
        unsigned* bar = b.bar;
        __builtin_amdgcn_s_waitcnt(0);
        unsigned nloc = b.st[0], nx = b.st[1];
        if (nloc == 0u) { xcd_barrier_complete(bar, b.x, nloc, nx); b.st[0] = nloc; b.st[1] = nx; }
        const unsigned old = xb_add(&bar[XB_XSUB(b.x)], 1u);
        const unsigned gen = old / nloc;
        if (old + 1u == (gen + 1u) * nloc) {
            __builtin_amdgcn_fence(__ATOMIC_RELEASE, "agent");
            asm volatile("s_waitcnt vmcnt(0)" ::: "memory");
            const unsigned og = xb_add(&bar[XB_TOP], 1u);
            const unsigned tg = og / nx;
            if (og + 1u == (tg + 1u) * nx) xb_add(&bar[XB_TOPGEN], 1u);
            else XB_SPIN(xb_ld(&bar[XB_TOPGEN]) == tg, bar);
            __builtin_amdgcn_fence(__ATOMIC_ACQUIRE, "agent");
            xb_add(&bar[XB_XGEN(b.x)], 1u);
            asm volatile("s_waitcnt vmcnt(0)" ::: "memory");
        } else {
            XB_SPIN(xb_ld(&bar[XB_XGEN(b.x)]) == gen, bar);
            __builtin_amdgcn_fence(__ATOMIC_ACQUIRE, "agent");
            asm volatile("s_waitcnt vmcnt(0)" ::: "memory");
        }
    }
    __syncthreads();
}

__global__ void __launch_bounds__(512) mega(Params p_arg) {
    extern __shared__ __attribute__((aligned(16))) unsigned char lds[];
    cg::grid_group grid = cg::this_grid();
    const int ph_lo = p_arg.ph_lo, ph_hi = p_arg.ph_hi;
    if (ph_lo < 0) grid.sync();
    volatile LAS unsigned* xbst = (volatile LAS unsigned*)(LAS unsigned char*)(lds + LDS_BYTES - 16);
    const int wid0 = __builtin_amdgcn_readfirstlane((int)(threadIdx.x >> 6));
    if (wid0 == 0 && hw_lane() == 0) { xbst[0] = 0u; xbst[1] = 0u; }
    __syncthreads();
    XcdBarrier xb; xb.bar = (unsigned*)(p_arg.ws + WS_BAR); xb.x = 0; xb.st = xbst;
    if (ph_hi - ph_lo > 1) xb = xcd_barrier_post(wid0, (unsigned*)(p_arg.ws + WS_BAR), xbst);
    for (int ph = ph_lo; ph < ph_hi; ++ph) {
        const __attribute__((address_space(4))) Params* pp = (const __attribute__((address_space(4))) Params*)__builtin_amdgcn_kernarg_segment_ptr();
        asm volatile("" : "+s"(pp));
        Params p;
        p.x = pp->x; p.meta = pp->meta; p.g_norm = pp->g_norm; p.gla_w_in = pp->gla_w_in; p.gla_wgu = pp->gla_wgu; p.gla_bg = pp->gla_bg; p.gla_gn = pp->gla_gn; p.gla_w_out = pp->gla_w_out;
        p.diff_w_in = pp->diff_w_in; p.diff_lam = pp->diff_lam; p.diff_gn = pp->diff_gn; p.diff_w_out = pp->diff_w_out; p.rel_bias = pp->rel_bias; p.g_final = pp->g_final; p.out = pp->out; p.ws = pp->ws;
        p.ph_lo = ph_lo; p.ph_hi = ph_hi;
        bf16_t* act = (bf16_t*)(p.ws + WS_ACT); const bf16_t* hn = (const bf16_t*)(p.ws + WS_HN);
        const bf16_t* win = (const bf16_t*)(p.ws + WS_WIN); const bf16_t* wout = (const bf16_t*)(p.ws + WS_WOUT); const bf16_t* wg = (const bf16_t*)(p.ws + WS_WG);
        float* hmeta = (float*)(p.ws + WS_HMETA);
        const int G = opaque_gdim(), bid = opaque_bid();
        int L, kind;
        if (ph == 0) { L = 0; kind = 0; }
        else if (ph <= 6) { L = 0; kind = ph; }
        else if (ph <= 11) { L = 1; kind = ph; }
        else if (ph <= 17) { L = 2; kind = ph - 11; }
        else { L = 3; kind = ph - 11; }
        for (int rep = 0; rep < (((DBG_DOUBLE >> kind) & 1) && !(kind == 11 && L == 3) ? 2 : 1); ++rep) {
        if (EN(0) && kind == 0) { phase_bias(wid0, p); phase_norm(wid0, p, 0); phase_wconv(wid0, p, 0, lds); }
        else if (EN(1) && kind == 1) {
            pg8::Gemm g{hn, win, MREG, 6144, 1024}; pg8::StaticOrder S; S.init(MREG, 6144, G, bid);
            pg8::EpiGen<StGlaIn> E{StGlaIn{act}};
            pg8::gemm_phase(wid0, (LAS unsigned char*)lds, g, S, E);
            mini_gemm(wid0, hn, 1024, MREG, 4, win, 1024, 6144, StGlaIn{act});
            glr_gemm(wid0, hn, wg, (float*)(p.ws + WS_GLR));
        }
        else if (EN(2) && kind == 2) phase_prep(wid0, p, L, lds, DRY(rep));
        else if (EN(3) && kind == 3) phase_scan(wid0, p, lds, DRY(rep));
        else if (EN(4) && kind == 4) phase_gate(wid0, p, L, DRY(rep));
        else if (EN(5) && (kind == 5 || kind == 10)) {
            const bf16_t* A = (kind == 5) ? act + RALLOC * 4096 : act;
            const float* hsrc = (L == 0) ? p.x : p.out; const float* msrc = (L == 0) ? p.meta : hmeta;
            pg8::Gemm g{A, wout, MREG, 1024, 2048}; pg8::StaticOrder S; S.init(MREG, 1024, G, bid);
            pg8::EpiGen<StResid> E{StResid{hsrc, p.out, 0, DRY(rep)}};
            pg8::gemm_phase(wid0, (LAS unsigned char*)lds, g, S, E);
            mini_gemm(wid0, A, 2048, MREG, 1, wout, 2048, 1024, StResid{msrc, hmeta, MREG, DRY(rep)});
        }
        else if (EN(6) && (kind == 6 || kind == 11)) {
            if (L == 3) phase_final(wid0, p);
            else { phase_norm(wid0, p, L + 1); phase_wconv(wid0, p, L + 1, lds); }
        }
        else if (EN(7) && kind == 7) {
            pg8::Gemm g{hn, win, MREG, 6144, 1024}; pg8::StaticOrder S; S.init(MREG, 6144, G, bid);
            pg8::EpiGen<StDiffIn> E{StDiffIn{act}};
            pg8::gemm_phase(wid0, (LAS unsigned char*)lds, g, S, E);
            mini_gemm(wid0, hn, 1024, MREG, 4, win, 1024, 6144, StDiffIn{act});
        }
        else if (EN(8) && kind == 8) phase_attn(wid0, p, L, lds, DRY(rep));
        else if (EN(9) && kind == 9) {
            pg8::Gemm g{hn, win + (size_t)6144 * 1024, MREG, 2048, 1024}; pg8::StaticOrder S; S.init(MREG, 2048, G, bid);
            pg8::EpiGen<StZGate> E{StZGate{act, DRY(rep)}};
            pg8::gemm_phase(wid0, (LAS unsigned char*)lds, g, S, E);
            mini_gemm(wid0, hn, 1024, MREG, 1, win + (size_t)6144 * 1024, 1024, 2048, StZGate{act, DRY(rep)});
        }
        }
        if (ph + 1 < ph_hi) xcd_barrier(wid0, xb);
    }
}

extern "C" void kernel_launch(void* const* d_in, const int* in_sizes, int n_in, void* d_out, int out_size, void* d_ws, size_t ws_size, hipStream_t stream) {
    static int grid = 0;
    if (grid == 0) {
        if (ws_size < WS_END) { fprintf(stderr, "kernel_launch: workspace too small: %zu < %zu\n", ws_size, (size_t)WS_END); grid = -1; return; }
        int dev = 0, cus = 0, per_cu = 0;
        hipGetDevice(&dev); hipDeviceGetAttribute(&cus, hipDeviceAttributeMultiprocessorCount, dev);
        if (hipFuncSetAttribute((const void*)mega, hipFuncAttributeMaxDynamicSharedMemorySize, LDS_BYTES) != hipSuccess) { fprintf(stderr, "kernel_launch: hipFuncSetAttribute failed\n"); grid = -1; return; }
        if (hipOccupancyMaxActiveBlocksPerMultiprocessor(&per_cu, (const void*)mega, 512, LDS_BYTES) != hipSuccess || per_cu < 1) per_cu = 1;
        (void)hipGetLastError();
        grid = 256; (void)cus;
        if (grid <= 0) grid = 256;
    }
    if (grid < 0) return;
    Params p{};
    p.x = (const float*)d_in[0]; p.meta = (const float*)d_in[1]; p.g_norm = (const float*)d_in[2]; p.gla_w_in = (const float*)d_in[3]; p.gla_wgu = (const float*)d_in[4];
    p.gla_bg = (const float*)d_in[5]; p.gla_gn = (const float*)d_in[6]; p.gla_w_out = (const float*)d_in[7]; p.diff_w_in = (const float*)d_in[8]; p.diff_lam = (const float*)d_in[9];
    p.diff_gn = (const float*)d_in[10]; p.diff_w_out = (const float*)d_in[11]; p.rel_bias = (const float*)d_in[12]; p.g_final = (const float*)d_in[13];
    p.out = (float*)d_out; p.ws = (unsigned char*)d_ws;
    if (hipMemsetAsync((char*)d_ws + WS_BAR, 0, 16384, stream) != hipSuccess) { fprintf(stderr, "kernel_launch: memset failed\n"); return; }
#if MULTI_LAUNCH
#ifndef DBG_LAST
#define DBG_LAST 21
#endif
    for (int ph = 0; ph < NPHASES; ++ph) {
        if (ph > DBG_LAST && ph != NPHASES - 1) continue;
        if ((DBG_SKIP >> ph) & 1) continue;
        p.ph_lo = ph; p.ph_hi = ph + 1;
        hipLaunchKernelGGL(mega, dim3(grid), dim3(512), LDS_BYTES, stream, p);
    }
#else
    p.ph_lo = 0; p.ph_hi = NPHASES;
    void* args[] = {&p};
    hipError_t e = hipLaunchCooperativeKernel((void*)mega, dim3(grid), dim3(512), args, LDS_BYTES, stream);
    if (e != hipSuccess) fprintf(stderr, "cooperative launch failed: %s (grid %d)\n", hipGetErrorString(e), grid);
#endif
}
```

```cpp
#include <hip/hip_runtime.h>
#include <hip/hip_cooperative_groups.h>
#include <cstdio>
namespace cg = cooperative_groups;

#define DBG_LAST 21
#define DBG_SKIP 0x0
#ifndef DBG_DOUBLE
#define DBG_DOUBLE 0x0
#endif
#define DRY(rep) ((((DBG_DOUBLE >> kind) & 1) != 0) && (rep) == 0)
#ifndef MULTI_LAUNCH
#define MULTI_LAUNCH 0
#endif

#ifndef ONLY
#define ONLY -1
#endif
#define EN(k) (ONLY == -1 || ONLY == (k))
#define DI __device__ __forceinline__
#define LAS __attribute__((address_space(3)))
typedef unsigned short bf16_t;
typedef short bf16x8 __attribute__((ext_vector_type(8)));
typedef short s16x4 __attribute__((ext_vector_type(4)));
typedef float f32x4 __attribute__((ext_vector_type(4)));
typedef float f32x16 __attribute__((ext_vector_type(16)));
typedef unsigned u32x4 __attribute__((ext_vector_type(4)));
typedef unsigned u32x2 __attribute__((ext_vector_type(2)));

constexpr int MREG = 32768;
constexpr int RCONT = MREG + 64;
constexpr size_t RALLOC = MREG + 128;
constexpr size_t WS_HMETA = 0;
constexpr size_t WS_BIAS = 65536;
constexpr size_t WS_OMETA = 65536 + 8192;
constexpr size_t WS_BAR = 196608;
constexpr size_t WS_WIN = 262144;
constexpr size_t WS_WOUT = WS_WIN + 16777216;
constexpr size_t WS_WG = WS_WOUT + 4194304;
constexpr size_t WS_HN = WS_WG + 32768;
constexpr size_t WS_ACT = WS_HN + RALLOC * 2048;
constexpr size_t WS_ATTN = WS_ACT + RALLOC * 12288;
constexpr size_t WS_E = WS_ATTN + (size_t)513 * 4 * 4096 * 2;
constexpr size_t WS_GLR = WS_E + (size_t)513 * 4 * 256 * 4;
constexpr size_t WS_END = WS_GLR + RALLOC * 64;
constexpr int LDS_BYTES = 147456;
constexpr int NPHASES = 23;

struct Params {
    const float *x, *meta, *g_norm, *gla_w_in, *gla_wgu, *gla_bg, *gla_gn, *gla_w_out, *diff_w_in, *diff_lam, *diff_gn, *diff_w_out, *rel_bias, *g_final;
    float* out; unsigned char* ws; int ph_lo, ph_hi;
};

DI int opaque_bid() { int b = blockIdx.x; asm volatile("" : "+s"(b)); return b; }
DI int opaque_gdim() { int g = gridDim.x; asm volatile("" : "+s"(g)); return g; }
DI int hw_lane() { unsigned z = 0u; asm volatile("" : "+s"(z)); return (int)__builtin_amdgcn_mbcnt_hi(~0u, __builtin_amdgcn_mbcnt_lo(~0u, z)); }
DI int opaque_tid(int wid0) { int w = wid0; asm volatile("" : "+s"(w)); return w * 64 + hw_lane(); }
typedef __bf16 bf16v2_t __attribute__((ext_vector_type(2)));
typedef float f32x2_t __attribute__((ext_vector_type(2)));
DI unsigned cvt_pk_bf16(float lo, float hi) { const f32x2_t v = {lo, hi}; const bf16v2_t b = __builtin_convertvector(v, bf16v2_t); return __builtin_bit_cast(unsigned, b); }
DI float bf2f(short b) { return __uint_as_float(((unsigned)(unsigned short)b) << 16); }
#define SWZ_XOR(v, x) __int_as_float(__builtin_amdgcn_ds_swizzle(__float_as_int(v), 0x1F | ((x) << 10)))
DI float half_sum(float v) { v += SWZ_XOR(v, 1); v += SWZ_XOR(v, 2); v += SWZ_XOR(v, 4); v += SWZ_XOR(v, 8); v += SWZ_XOR(v, 16); return v; }
DI float wave_sum(float v) { v = half_sum(v); auto rr = __builtin_amdgcn_permlane32_swap(__float_as_uint(v), __float_as_uint(v), false, false); return __uint_as_float(rr[0]) + __uint_as_float(rr[1]); }
DI int crow(int r, int hi) { return (r & 3) + 8 * (r >> 2) + 4 * hi; }
#define MFMA16(a, b, c) __builtin_amdgcn_mfma_f32_16x16x32_bf16((a), (b), (c), 0, 0, 0)
#define MFMA32(a, b, c) __builtin_amdgcn_mfma_f32_32x32x16_bf16((a), (b), (c), 0, 0, 0)

namespace pg8 {
constexpr int BM = 256, BK = 64, HALF = 128, HTB = HALF * BK * 2, STAGE_BYTES = 8 * HTB, NXCD = 8, WGM = 8;
DI int lds_byte(int r, int c) { const int st = (r >> 4) * 2 + (c >> 5), rr = r & 15, cc = c & 31, ob = rr * 64 + cc * 2; return st * 1024 + (ob ^ (((ob >> 9) & 1) << 5)); }
DI void stage_rc(int b, int& R, int& C) { const int st = b / 1024, sb = b % 1024, swz = sb ^ (((sb >> 9) & 1) << 5); R = (st >> 1) * 16 + swz / 64; C = (st & 1) * 32 + (swz % 64) / 2; }
DI int perm32(int rho) { const int n = rho >> 4, i = rho & 15; return 8 * (i >> 2) + 4 * n + (i & 3); }
struct Unit { int pm, pn; };
struct Gemm { const bf16_t* A; const bf16_t* Bt; int M, N, K; };
struct StaticOrder {
    int nM, nN, nwg, G, c;
    DI void init(int M, int N, int G_, int c_) { nM = M / BM; nN = N / BM; nwg = nM * nN; G = G_; c = c_; }
    DI bool next(int i, Unit& u) const {
        const long L = (long)i * G + c; if (L >= nwg) return false;
        int wgid = (int)L; { const int q = nwg / NXCD, r = nwg % NXCD, xcd = wgid % NXCD, off = wgid / NXCD; wgid = (xcd < r ? xcd * (q + 1) : r * (q + 1) + (xcd - r) * q) + off; }
        const int nig = WGM * nN, gid = wgid / nig, fm = gid * WGM, gsz = (nM - fm) < WGM ? (nM - fm) : WGM;
        u.pm = fm + ((wgid % nig) % gsz); u.pn = (wgid % nig) / gsz; return true;
    }
};
template <class F> struct EpiGen {
    F f;
    DI void operator()(const f32x4 (&acc)[2][2][4][2], const Unit& u, int wr, int wc, int fr, int fq) const {
        const int row0 = u.pm * BM + wr * 64 + fr, col0 = u.pn * BM + wc * 32 + 8 * fq;
#pragma unroll
        for (int ai = 0; ai < 2; ++ai)
#pragma unroll
            for (int m = 0; m < 4; ++m)
#pragma unroll
                for (int bj = 0; bj < 2; ++bj) f.store8(row0 + ai * HALF + m * 16, col0 + bj * HALF, acc[ai][bj][m][0], acc[ai][bj][m][1]);
    }
};

template <class Epi>
DI void gemm_phase(int wid0, LAS unsigned char* lds, const Gemm g, const StaticOrder& S, const Epi& E) {
    const int tid = opaque_tid(wid0), wid = __builtin_amdgcn_readfirstlane(tid >> 6), lane = tid & 63, wr = wid >> 2, wc = wid & 3, fr = lane & 15, fq = lane >> 4;
    const int K = g.K, nt = K / BK;
    unsigned voffA[2], voffB[2];
#pragma unroll
    for (int i = 0; i < 2; ++i) { int R, C; stage_rc(tid * 16 + i * 8192, R, C); const int Rb = (R & ~31) + perm32(R & 31); voffA[i] = (unsigned)(R * K + C) * 2u; voffB[i] = (unsigned)(Rb * K + C) * 2u; }
    const size_t kstep = (size_t)(BK * 2);
    const size_t hstep = (size_t)HALF * K * 2;
    const size_t tstep = 2 * hstep;
    const unsigned ldsw = (unsigned)wid * 1024u;
    const int aoff = lds_byte(wr * 64 + fr, fq * 8), boff = lds_byte(wc * 32 + fr, fq * 8);
#define PG8_SA(b, h) (((b) * 2 + (h)) * HTB)
#define PG8_SB(b, h) ((4 + (b) * 2 + (h)) * HTB)
#define PG8_STAGE(bufoff, gbase, voff) do { _Pragma("unroll") for (int _i = 0; _i < 2; ++_i) \
        __builtin_amdgcn_global_load_lds((const unsigned*)((const char*)(gbase) + (voff)[_i]), (LAS unsigned*)(lds + (bufoff) + ldsw + _i * 8192), 16, 0, 0); } while (0)
#define PG8_LDA(dst, b, h) do { _Pragma("unroll") for (int m = 0; m < 4; ++m) _Pragma("unroll") for (int k = 0; k < 2; ++k) dst[m][k] = *(const LAS bf16x8*)(lds + PG8_SA(b, h) + aoff + m * 2048 + k * 1024); } while (0)
#define PG8_LDB(dst, b, h) do { _Pragma("unroll") for (int n = 0; n < 2; ++n) _Pragma("unroll") for (int k = 0; k < 2; ++k) dst[n][k] = *(const LAS bf16x8*)(lds + PG8_SB(b, h) + boff + n * 2048 + k * 1024); } while (0)
#define PG8_MMA(ai, bj, At, Bt) do { __builtin_amdgcn_s_setprio(1); _Pragma("unroll") for (int m = 0; m < 4; ++m) _Pragma("unroll") for (int n = 0; n < 2; ++n) _Pragma("unroll") for (int k = 0; k < 2; ++k) \
        acc[ai][bj][m][n] = __builtin_amdgcn_mfma_f32_16x16x32_bf16(Bt[n][k], At[m][k], acc[ai][bj][m][n], 0, 0, 0); __builtin_amdgcn_s_setprio(0); } while (0)
#define PG8_WAIT_V(n) asm volatile("s_waitcnt vmcnt(" #n ")" ::: "memory")
#define PG8_WAIT_L(n) asm volatile("s_waitcnt lgkmcnt(" #n ")" ::: "memory")
#define PG8_BAR __builtin_amdgcn_s_barrier()
#define PG8_SCHED __builtin_amdgcn_sched_barrier(0)
    Unit cur, nxt; int ui = 0;
    if (!S.next(0, cur)) return;
    f32x4 acc[2][2][4][2];
#pragma unroll
    for (int a = 0; a < 2; ++a)
#pragma unroll
        for (int b = 0; b < 2; ++b)
#pragma unroll
            for (int m = 0; m < 4; ++m)
#pragma unroll
                for (int n = 0; n < 2; ++n) acc[a][b][m][n] = (f32x4){0.f, 0.f, 0.f, 0.f};
    bf16x8 At[4][2], B0[2][2], B1[2][2];
    const char* cA = (const char*)g.A + (size_t)cur.pm * tstep; const char* cB = (const char*)g.Bt + (size_t)cur.pn * tstep;
    PG8_STAGE(PG8_SB(0, 0), cB, voffB); PG8_STAGE(PG8_SB(0, 1), cB + hstep, voffB); PG8_STAGE(PG8_SA(0, 0), cA, voffA); PG8_STAGE(PG8_SA(0, 1), cA + hstep, voffA);
    if (wr == 1) PG8_BAR;
    PG8_WAIT_V(2); PG8_BAR;
    PG8_STAGE(PG8_SB(1, 0), cB + kstep, voffB); PG8_STAGE(PG8_SA(1, 0), cA + kstep, voffA); PG8_STAGE(PG8_SB(1, 1), cB + hstep + kstep, voffB);
    PG8_WAIT_V(6); PG8_BAR;
    for (;;) {
        const bool has_next = S.next(ui + 1, nxt);
        const char* nA = has_next ? (const char*)g.A + (size_t)nxt.pm * tstep : cA; const char* nB = has_next ? (const char*)g.Bt + (size_t)nxt.pn * tstep : cB;
        for (int t = 0; t < nt; t += 2) {
            const bool last = (t == nt - 2);
            const char* a1 = cA + (size_t)(t + 1) * kstep;
            const char* a2 = last ? nA : cA + (size_t)(t + 2) * kstep; const char* b2 = last ? nB : cB + (size_t)(t + 2) * kstep;
            const char* a3 = a2 + kstep; const char* b3 = b2 + kstep;
            PG8_LDB(B0, 0, 0); PG8_LDB(B1, 0, 1); PG8_SCHED; PG8_LDA(At, 0, 0); PG8_STAGE(PG8_SA(1, 1), a1 + hstep, voffA);
            PG8_WAIT_V(8); PG8_WAIT_L(0); PG8_BAR; PG8_MMA(0, 0, At, B0); PG8_MMA(0, 1, At, B1); PG8_BAR; PG8_SCHED;
            PG8_LDA(At, 0, 1); PG8_STAGE(PG8_SB(0, 0), b2, voffB); PG8_STAGE(PG8_SB(0, 1), b2 + hstep, voffB); PG8_STAGE(PG8_SA(0, 0), a2, voffA);
            PG8_WAIT_V(8); PG8_WAIT_L(0); PG8_BAR; PG8_MMA(1, 0, At, B0); PG8_MMA(1, 1, At, B1); PG8_BAR; PG8_SCHED;
            PG8_LDB(B0, 1, 0); PG8_LDB(B1, 1, 1); PG8_SCHED; PG8_LDA(At, 1, 0); PG8_STAGE(PG8_SA(0, 1), a2 + hstep, voffA);
            PG8_WAIT_V(8); PG8_WAIT_L(0); PG8_BAR; PG8_MMA(0, 0, At, B0); PG8_MMA(0, 1, At, B1); PG8_BAR; PG8_SCHED;
            PG8_LDA(At, 1, 1); PG8_STAGE(PG8_SB(1, 0), b3, voffB); PG8_STAGE(PG8_SB(1, 1), b3 + hstep, voffB); PG8_STAGE(PG8_SA(1, 0), a3, voffA);
            PG8_WAIT_V(8); PG8_WAIT_L(0); PG8_BAR; PG8_MMA(1, 0, At, B0); PG8_MMA(1, 1, At, B1); PG8_BAR; PG8_SCHED;
        }
        if (wr == 0) PG8_BAR;
        E(acc, cur, wr, wc, fr, fq);
        if (!has_next) break;
#pragma unroll
        for (int a = 0; a < 2; ++a)
#pragma unroll
            for (int b = 0; b < 2; ++b)
#pragma unroll
                for (int m = 0; m < 4; ++m)
#pragma unroll
                    for (int n = 0; n < 2; ++n) acc[a][b][m][n] = (f32x4){0.f, 0.f, 0.f, 0.f};
        cur = nxt; cA = nA; cB = nB; ++ui;
        if (wr == 1) PG8_BAR;
    }
    PG8_WAIT_V(0);
    PG8_BAR;
#undef PG8_SA
#undef PG8_SB
#undef PG8_STAGE
#undef PG8_LDA
#undef PG8_LDB
#undef PG8_MMA
#undef PG8_WAIT_V
#undef PG8_WAIT_L
#undef PG8_BAR
#undef PG8_SCHED
}
}

struct StGlaIn {
    bf16_t* act;
    DI void operator()(int row, int col, f32x4 a) const {
        bf16_t* d;
        if (col < 1024) d = act + (size_t)row * 1024 + col;
        else if (col < 2048) d = act + RALLOC * 1024 + (size_t)row * 1024 + (col - 1024);
        else if (col < 4096) d = act + RALLOC * 2048 + (size_t)row * 2048 + (col - 2048);
        else d = act + RALLOC * 4096 + (size_t)row * 2048 + (col - 4096);
        u32x2 w; w.x = cvt_pk_bf16(a[0], a[1]); w.y = cvt_pk_bf16(a[2], a[3]); *(u32x2*)d = w;
    }
    DI void store8(int row, int col, f32x4 a, f32x4 b) const {
        bf16_t* d;
        if (col < 1024) d = act + (size_t)row * 1024 + col;
        else if (col < 2048) d = act + RALLOC * 1024 + (size_t)row * 1024 + (col - 1024);
        else if (col < 4096) d = act + RALLOC * 2048 + (size_t)row * 2048 + (col - 2048);
        else d = act + RALLOC * 4096 + (size_t)row * 2048 + (col - 4096);
        u32x4 w; w.x = cvt_pk_bf16(a[0], a[1]); w.y = cvt_pk_bf16(a[2], a[3]); w.z = cvt_pk_bf16(b[0], b[1]); w.w = cvt_pk_bf16(b[2], b[3]); *(u32x4*)d = w;
    }
};
struct StDiffIn {
    bf16_t* act;
    DI void operator()(int row, int col, f32x4 a) const {
        bf16_t* d = act + (size_t)(col >> 11) * (RALLOC * 2048) + (size_t)row * 2048 + (col & 2047);
        u32x2 w; w.x = cvt_pk_bf16(a[0], a[1]); w.y = cvt_pk_bf16(a[2], a[3]); *(u32x2*)d = w;
    }
    DI void store8(int row, int col, f32x4 a, f32x4 b) const {
        bf16_t* d = act + (size_t)(col >> 11) * (RALLOC * 2048) + (size_t)row * 2048 + (col & 2047);
        u32x4 w; w.x = cvt_pk_bf16(a[0], a[1]); w.y = cvt_pk_bf16(a[2], a[3]); w.z = cvt_pk_bf16(b[0], b[1]); w.w = cvt_pk_bf16(b[2], b[3]); *(u32x4*)d = w;
    }
};
struct StZGate {
    bf16_t* o; bool dry;
    DI void operator()(int row, int col, f32x4 a) const {
        bf16_t* d = o + (size_t)row * 2048 + col;
        const u32x2 ov = *(const u32x2*)d;
        float of[4] = {__uint_as_float(ov.x << 16), __uint_as_float(ov.x & 0xffff0000u), __uint_as_float(ov.y << 16), __uint_as_float(ov.y & 0xffff0000u)};
        float y[4];
#pragma unroll
        for (int i = 0; i < 4; ++i) { const float z = a[i]; y[i] = z / (1.f + __expf(-z)) * of[i]; }
        u32x2 w; w.x = cvt_pk_bf16(y[0], y[1]); w.y = cvt_pk_bf16(y[2], y[3]); if (!dry) *(u32x2*)d = w;
    }
    DI void store8(int row, int col, f32x4 a, f32x4 b) const {
        bf16_t* d = o + (size_t)row * 2048 + col;
        const u32x4 ov = *(const u32x4*)d;
        const unsigned ow[4] = {ov.x, ov.y, ov.z, ov.w}; float y[8];
#pragma unroll
        for (int i = 0; i < 8; ++i) { const float z = i < 4 ? a[i] : b[i - 4]; const float of = (i & 1) ? __uint_as_float(ow[i >> 1] & 0xffff0000u) : __uint_as_float(ow[i >> 1] << 16); y[i] = z / (1.f + __expf(-z)) * of; }
        u32x4 w; w.x = cvt_pk_bf16(y[0], y[1]); w.y = cvt_pk_bf16(y[2], y[3]); w.z = cvt_pk_bf16(y[4], y[5]); w.w = cvt_pk_bf16(y[6], y[7]); if (!dry) *(u32x4*)d = w;
    }
};
struct StResid {
    const float* src; float* dst; int rowoff; bool dry;
    DI void operator()(int row, int col, f32x4 a) const {
        const size_t o = (size_t)(row - rowoff) * 1024 + col;
        const f32x4 s = *(const f32x4*)(src + o); if (!dry) *(f32x4*)(dst + o) = s + a;
    }
    DI void store8(int row, int col, f32x4 a, f32x4 b) const {
        const size_t o = (size_t)(row - rowoff) * 1024 + col;
        const f32x4 s0 = *(const f32x4*)(src + o), s1 = *(const f32x4*)(src + o + 4);
        if (!dry) { *(f32x4*)(dst + o) = s0 + a; *(f32x4*)(dst + o + 4) = s1 + b; }
    }
};
struct StGlr {
    float* glr;
    DI void operator()(int row, int col, f32x4 a) const { *(f32x4*)(glr + (size_t)row * 16 + col) = a; }
};

template <class St>
DI void mini_gemm(int wid0, const bf16_t* A, int lda, int arow0, int nrt, const bf16_t* Bt, int K, int N, const St& st) {
    const int tid_ = opaque_tid(wid0), lane = tid_ & 63, wave = tid_ >> 6, nw = opaque_gdim() * 8, nct = N / 16;
    const int gw = (wave * opaque_gdim() + opaque_bid());
    for (int t = gw; t < nrt * nct; t += nw) {
        const int rt = t % nrt, ct = t / nrt;
        const bf16_t* ap = A + (size_t)(arow0 + rt * 16 + (lane & 15)) * lda + 8 * (lane >> 4);
        const bf16_t* bp = Bt + (size_t)(ct * 16 + (lane & 15)) * K + 8 * (lane >> 4);
        f32x4 acc0 = (f32x4){0.f, 0.f, 0.f, 0.f}, acc1 = (f32x4){0.f, 0.f, 0.f, 0.f};
        for (int k0 = 0; k0 < K; k0 += 256) {
            bf16x8 a[8], b[8];
#pragma unroll
            for (int j = 0; j < 8; ++j) { a[j] = *(const bf16x8*)(ap + k0 + 32 * j); b[j] = *(const bf16x8*)(bp + k0 + 32 * j); }
#pragma unroll
            for (int j = 0; j < 8; j += 2) { acc0 = MFMA16(b[j], a[j], acc0); acc1 = MFMA16(b[j + 1], a[j + 1], acc1); }
        }
        st(arow0 + rt * 16 + (lane & 15), ct * 16 + 4 * (lane >> 4), acc0 + acc1);
    }
}
DI void glr_gemm(int wid0, const bf16_t* hn, const bf16_t* WgT, float* glr) {
    const int tid_ = opaque_tid(wid0), lane = tid_ & 63, wave = tid_ >> 6, nw = opaque_gdim() * 8;
    const int gw = ((7 - wave) * opaque_gdim() + opaque_bid());
    for (int t = gw; t < RCONT / 64; t += nw) {
        const bf16_t* ap = hn + (size_t)(t * 64 + (lane & 15)) * 1024 + 8 * (lane >> 4);
        const bf16_t* bp = WgT + (size_t)(lane & 15) * 1024 + 8 * (lane >> 4);
        f32x4 acc[4];
#pragma unroll
        for (int c = 0; c < 4; ++c) acc[c] = (f32x4){0.f, 0.f, 0.f, 0.f};
#pragma unroll 4
        for (int k0 = 0; k0 < 1024; k0 += 32) {
            const bf16x8 b = *(const bf16x8*)(bp + k0);
#pragma unroll
            for (int c = 0; c < 4; ++c) { const bf16x8 a = *(const bf16x8*)(ap + (size_t)c * 16 * 1024 + k0); acc[c] = MFMA16(b, a, acc[c]); }
        }
#pragma unroll
        for (int c = 0; c < 4; ++c) *(f32x4*)(glr + (size_t)(t * 64 + c * 16 + (lane & 15)) * 16 + 4 * (lane >> 4)) = acc[c];
    }
}

DI void phase_bias(int wid0, const Params& p) {
    float* T = (float*)(p.ws + WS_BIAS);
    const int i = opaque_bid() * 512 + opaque_tid(wid0);
    if (i < 8 * 129) {
        const int h = i / 129, n = i % 129; int bucket;
        if (n < 16) bucket = n;
        else { const float nf = (float)n; int lg = 16 + (int)(logf(nf / 16.f) / logf(8.f) * 16.f); bucket = lg < 31 ? lg : 31; }
        T[i] = p.rel_bias[bucket * 8 + h] * 1.4426950408889634f;
    }
}
DI void phase_norm(int wid0, const Params& p, int L) {
    const float* hreg = (L == 0) ? p.x : p.out; const float* hmeta = (L == 0) ? p.meta : (const float*)(p.ws + WS_HMETA);
    const float* g = p.g_norm + L * 1024; bf16_t* hn = (bf16_t*)(p.ws + WS_HN);
    const int tid_ = opaque_tid(wid0), wave = tid_ >> 6, lane = tid_ & 63, stride = opaque_gdim() * 8;
    f32x4 gv[4];
#pragma unroll
    for (int i = 0; i < 4; ++i) gv[i] = *(const f32x4*)(g + i * 256 + lane * 4);
    for (int row0 = opaque_bid() * 8 + wave; row0 < RCONT; row0 += 2 * stride) {
        f32x4 v[2][4]; float ss[2] = {0.f, 0.f};
#pragma unroll
        for (int q = 0; q < 2; ++q) {
            const int row = row0 + q * stride;
            if (row < MREG + 16) {
                const float* src = row < MREG ? hreg + (size_t)row * 1024 : hmeta + (size_t)(row - MREG) * 1024;
#pragma unroll
                for (int i = 0; i < 4; ++i) v[q][i] = *(const f32x4*)(src + i * 256 + lane * 4);
            } else {
#pragma unroll
                for (int i = 0; i < 4; ++i) v[q][i] = (f32x4){0.f, 0.f, 0.f, 0.f};
            }
        }
#pragma unroll
        for (int q = 0; q < 2; ++q) {
#pragma unroll
            for (int i = 0; i < 4; ++i) ss[q] += v[q][i][0] * v[q][i][0] + v[q][i][1] * v[q][i][1] + v[q][i][2] * v[q][i][2] + v[q][i][3] * v[q][i][3];
            ss[q] = wave_sum(ss[q]);
        }
#pragma unroll
        for (int q = 0; q < 2; ++q) {
            const int row = row0 + q * stride;
            if (row < RCONT) {
                const float rstd = rsqrtf(ss[q] * (1.f / 1024.f) + 1e-6f);
                bf16_t* dst = hn + (size_t)row * 1024;
#pragma unroll
                for (int i = 0; i < 4; ++i) {
                    u32x2 w; w.x = cvt_pk_bf16(v[q][i][0] * rstd * gv[i][0], v[q][i][1] * rstd * gv[i][1]); w.y = cvt_pk_bf16(v[q][i][2] * rstd * gv[i][2], v[q][i][3] * rstd * gv[i][3]);
                    *(u32x2*)(dst + i * 256 + lane * 4) = w;
                }
            }
        }
    }
}
DI void phase_final(int wid0, const Params& p) {
    const int tid_ = opaque_tid(wid0), wave = tid_ >> 6, lane = tid_ & 63;
    for (int row = opaque_bid() * 8 + wave; row < MREG; row += opaque_gdim() * 8) {
        float* src = p.out + (size_t)row * 1024;
        f32x4 v[4]; float ss = 0.f;
#pragma unroll
        for (int i = 0; i < 4; ++i) { v[i] = *(const f32x4*)(src + i * 256 + lane * 4); ss += v[i][0] * v[i][0] + v[i][1] * v[i][1] + v[i][2] * v[i][2] + v[i][3] * v[i][3]; }
        ss = wave_sum(ss);
        const float rstd = rsqrtf(ss * (1.f / 1024.f) + 1e-6f);
#pragma unroll
        for (int i = 0; i < 4; ++i) { const f32x4 gv = *(const f32x4*)(p.g_final + i * 256 + lane * 4); *(f32x4*)(src + i * 256 + lane * 4) = v[i] * rstd * gv; }
    }
}
DI void wconv_tile(const float* W, int ldw, int K, bf16_t* Bt, int k0, int n0, float* tile, int lane) {
#pragma unroll
    for (int i = 0; i < 16; ++i) {
        const int k = (lane >> 4) + 4 * i, n4 = (lane & 15) * 4;
        const f32x4 v = *(const f32x4*)(W + (size_t)(k0 + k) * ldw + n0 + n4);
        tile[k * 65 + n4] = v[0]; tile[k * 65 + n4 + 1] = v[1]; tile[k * 65 + n4 + 2] = v[2]; tile[k * 65 + n4 + 3] = v[3];
    }
    asm volatile("s_waitcnt lgkmcnt(0)" ::: "memory");
#pragma unroll
    for (int i = 0; i < 8; ++i) {
        const int n = (lane >> 3) + 8 * i, k8 = (lane & 7) * 8;
        float e[8];
#pragma unroll
        for (int j = 0; j < 8; ++j) e[j] = tile[(k8 + j) * 65 + n];
        u32x4 w; w.x = cvt_pk_bf16(e[0], e[1]); w.y = cvt_pk_bf16(e[2], e[3]); w.z = cvt_pk_bf16(e[4], e[5]); w.w = cvt_pk_bf16(e[6], e[7]);
        *(u32x4*)(Bt + (size_t)(n0 + n) * K + k0 + k8) = w;
    }
    asm volatile("s_waitcnt lgkmcnt(0)" ::: "memory");
}
DI void wconv_all(int wid0, const float* Win, int Nmain, int ldw, bf16_t* win, const float* Wout, bf16_t* wout, unsigned char* lds) {
    const int tid = opaque_tid(wid0), lane = tid & 63, wave = tid >> 6, nw = opaque_gdim() * 8;
    float* tile = (float*)(lds + wave * 16640);
    const int t1 = 16 * (Nmain / 64), ttot = t1 + 32 * 16;
    for (int t = wave * opaque_gdim() + opaque_bid(); t < ttot; t += nw) {
        if (t < t1) wconv_tile(Win, ldw, 1024, win, (t & 15) * 64, (t >> 4) * 64, tile, lane);
        else { const int u = t - t1; wconv_tile(Wout, 1024, 2048, wout, (u & 31) * 64, (u >> 5) * 64, tile, lane); }
    }
}
DI void phase_wconv(int wid0, const Params& p, int L, unsigned char* lds) {
    const int li = L >> 1;
    bf16_t* win = (bf16_t*)(p.ws + WS_WIN); bf16_t* wout = (bf16_t*)(p.ws + WS_WOUT); bf16_t* wg = (bf16_t*)(p.ws + WS_WG);
    if ((L & 1) == 0) {
        const float* W = p.gla_w_in + (size_t)li * 1024 * 6160;
        wconv_all(wid0, W, 6144, 6160, win, p.gla_w_out + (size_t)li * 2048 * 1024, wout, lds);
        for (int i = opaque_bid() * 512 + opaque_tid(wid0); i < 16 * 1024; i += opaque_gdim() * 512) { const int r = i >> 10, k = i & 1023; wg[i] = (bf16_t)(cvt_pk_bf16(W[(size_t)k * 6160 + 6144 + r], 0.f) & 0xffffu); }
    } else {
        wconv_all(wid0, p.diff_w_in + (size_t)li * 1024 * 8192, 8192, 8192, win, p.diff_w_out + (size_t)li * 2048 * 1024, wout, lds);
    }
}

DI void phase_prep(int wid0, const Params& p, int L, unsigned char* lds, bool dry) {
    const int gi = L >> 1, tid = opaque_tid(wid0), wave = tid >> 6, lane = tid & 63, r32 = lane & 31, hi = lane >> 5;
    const float* wgu = p.gla_wgu + (size_t)gi * 16 * 1024; const float* bg = p.gla_bg + (size_t)gi * 1024;
    bf16_t* act = (bf16_t*)(p.ws + WS_ACT); bf16_t* qb = act; bf16_t* kb = act + RALLOC * 1024;
    bf16_t* khT = (bf16_t*)(p.ws + WS_HN); bf16_t* attn = (bf16_t*)(p.ws + WS_ATTN); float* Eo = (float*)(p.ws + WS_E); const float* glr = (const float*)(p.ws + WS_GLR);
    float* bs = (float*)lds; float* tot = (float*)(lds + 65536); float* gl = (float*)(lds + 67584); bf16_t* qs = (bf16_t*)(lds + 71680); bf16_t* xs = (bf16_t*)(lds + 105472);
    for (int u = opaque_bid(); u < 513 * 4; u += opaque_gdim()) {
        const int g = u >> 2, hd = u & 3; const bool ismeta = (g == 512); const int row0 = ismeta ? MREG : g * 64;
        for (int i = tid; i < 1024; i += 512) gl[i] = glr[(size_t)row0 * 16 + i];
        bf16x8 qreg[4], kreg[4];
#pragma unroll
        for (int it = 0; it < 4; ++it) {
            const int gid = tid + 512 * it, i = gid >> 5, d8 = (gid & 31) * 8;
            const size_t goff = (size_t)(row0 + i) * 1024 + hd * 256 + d8;
            qreg[it] = *(const bf16x8*)(qb + goff); kreg[it] = *(const bf16x8*)(kb + goff);
        }
        __syncthreads();
        {
            const int d = tid & 255, ih = tid >> 8; float w[16];
#pragma unroll
            for (int r = 0; r < 16; ++r) w[r] = wgu[r * 1024 + hd * 256 + d];
            const float bgd = bg[hd * 256 + d]; float run = 0.f;
            for (int ii = 0; ii < 32; ++ii) {
                const int i = ih * 32 + ii; float x = bgd;
                const f32x4 g0 = *(const f32x4*)(gl + i * 16), g1 = *(const f32x4*)(gl + i * 16 + 4), g2 = *(const f32x4*)(gl + i * 16 + 8), g3 = *(const f32x4*)(gl + i * 16 + 12);
#pragma unroll
                for (int r = 0; r < 4; ++r) { x = fmaf(g0[r], w[r], x); x = fmaf(g1[r], w[4 + r], x); x = fmaf(g2[r], w[8 + r], x); x = fmaf(g3[r], w[12 + r], x); }
                float lgv = (fminf(x, 0.f) - __logf(1.f + __expf(-fabsf(x)))) * 0.0625f;
                if (ismeta && i >= 16) lgv = 0.f;
                run += lgv; bs[i * 256 + d] = run;
            }
            tot[ih * 256 + d] = run;
        }
        asm volatile("s_waitcnt vmcnt(0)" ::: "memory");
        __syncthreads();
#pragma unroll
        for (int it = 0; it < 4; ++it) {
            const int gid = tid + 512 * it, i = gid >> 5, d8 = (gid & 31) * 8;
            const bf16x8 qv = qreg[it]; const bf16x8 kv = kreg[it];
            float qt[8];
            const f32x4 bsv[2] = {*(const f32x4*)(bs + i * 256 + d8), *(const f32x4*)(bs + i * 256 + d8 + 4)};
            const f32x4 t0v[2] = {*(const f32x4*)(tot + d8), *(const f32x4*)(tot + d8 + 4)};
            const f32x4 t1v[2] = {*(const f32x4*)(tot + 256 + d8), *(const f32x4*)(tot + 256 + d8 + 4)};
#pragma unroll
            for (int e = 0; e < 8; ++e) {
                const float b = bsv[e >> 2][e & 3] + (i >= 32 ? t0v[e >> 2][e & 3] : 0.f); const float bl = t0v[e >> 2][e & 3] + t1v[e >> 2][e & 3];
                qt[e] = bf2f(qv[e]) * 0.0625f * __expf(b);
                const float kh = bf2f(kv[e]) * __expf(bl - b);
                xs[(d8 + e) * 64 + (i ^ (2 * ((d8 >> 3) & 31)))] = (bf16_t)(cvt_pk_bf16(kh, 0.f) & 0xffffu);
            }
            u32x4 w; w.x = cvt_pk_bf16(qt[0], qt[1]); w.y = cvt_pk_bf16(qt[2], qt[3]); w.z = cvt_pk_bf16(qt[4], qt[5]); w.w = cvt_pk_bf16(qt[6], qt[7]);
            {
                const int ob = (((i >> 4) * 8 + (d8 >> 5)) * 64 + ((d8 & 31) >> 3) * 16 + (i & 15)) * 16;
                *(u32x4*)(qb + (size_t)(row0 + (ob >> 9)) * 1024 + hd * 256 + ((ob & 511) >> 1)) = w;
            }
            *(u32x4*)(qs + i * 264 + d8) = w;
        }
        __syncthreads();
#pragma unroll
        for (int it = 0; it < 4; ++it) {
            const int gid = tid + 512 * it, d = gid >> 3, j8 = gid & 7, sw = (d >> 3) & 31;
            u32x4 w = *(const u32x4*)(xs + d * 64 + ((j8 ^ (sw >> 2)) * 8));
            if (sw & 1) w = (u32x4){w.y, w.x, w.w, w.z};
            if (sw & 2) w = (u32x4){w.z, w.w, w.x, w.y};
            *(u32x4*)(khT + (size_t)u * 16384 + ((((d >> 5) * 4 + (j8 >> 1)) * 64 + (j8 & 1) * 32 + (d & 31)) * 8)) = w;
        }
        if (tid < 256) Eo[(size_t)u * 256 + tid] = __expf(tot[tid] + tot[256 + tid]);
        __syncthreads();
#pragma unroll
        for (int it = 0; it < 4; ++it) {
            const int gid = tid + 512 * it, i = gid >> 5, d8 = (gid & 31) * 8; float kt[8];
            const f32x4 bsv[2] = {*(const f32x4*)(bs + i * 256 + d8), *(const f32x4*)(bs + i * 256 + d8 + 4)};
            const f32x4 t0v[2] = {*(const f32x4*)(tot + d8), *(const f32x4*)(tot + d8 + 4)};
#pragma unroll
            for (int e = 0; e < 8; ++e) { const float b = bsv[e >> 2][e & 3] + (i >= 32 ? t0v[e >> 2][e & 3] : 0.f); kt[e] = bf2f(kreg[it][e]) * __expf(-b); }
            u32x4 w; w.x = cvt_pk_bf16(kt[0], kt[1]); w.y = cvt_pk_bf16(kt[2], kt[3]); w.z = cvt_pk_bf16(kt[4], kt[5]); w.w = cvt_pk_bf16(kt[6], kt[7]);
            *(u32x4*)(xs + i * 264 + d8) = w;
        }
        __syncthreads();
        if (wave < 4) {
            const int ib = wave >> 1, jb = wave & 1; f32x16 acc;
#pragma unroll
            for (int i = 0; i < 16; ++i) acc[i] = 0.f;
            if (!(ib == 0 && jb == 1)) {
#pragma unroll
                for (int s = 0; s < 16; ++s) {
                    const bf16x8 a = *(const bf16x8*)(qs + (32 * ib + r32) * 264 + 16 * s + 8 * hi);
                    const bf16x8 b = *(const bf16x8*)(xs + (32 * jb + r32) * 264 + 16 * s + 8 * hi);
                    acc = MFMA32(a, b, acc);
                }
            }
#pragma unroll
            for (int i = 0; i < 16; ++i) {
                const int row = 32 * ib + crow(i, hi), col = 32 * jb + r32; const float v = (col <= row) ? acc[i] : 0.f;
                attn[(size_t)u * 4096 + ((((row >> 4) * 2 + (col >> 5)) * 64 + ((col & 31) >> 3) * 16 + (row & 15)) * 8) + (col & 7)] = (bf16_t)(cvt_pk_bf16(v, 0.f) & 0xffffu);
            }
        }
        __syncthreads();
    }
}

DI s16x4 tr_read0(unsigned addr) { s16x4 r; asm volatile("ds_read_b64_tr_b16 %0, %1" : "=&v"(r) : "v"(addr) : "memory"); return r; }
#define PK8(L, H) (bf16x8){L[0], L[1], L[2], L[3], H[0], H[1], H[2], H[3]}
DI void phase_scan(int wid0, const Params& p, unsigned char* lds, bool dry) {
    const int tid = opaque_tid(wid0), wave = __builtin_amdgcn_readfirstlane(tid >> 6), lane = tid & 63, r32 = lane & 31, hi = lane >> 5, l15 = lane & 15, l4 = lane >> 4;
    bf16_t* act = (bf16_t*)(p.ws + WS_ACT); const bf16_t* qb = act; bf16_t* vb = act + RALLOC * 2048;
    const bf16_t* khT = (const bf16_t*)(p.ws + WS_HN); const bf16_t* attn = (const bf16_t*)(p.ws + WS_ATTN); const float* Eo = (const float*)(p.ws + WS_E);
    bf16_t* ometa = (bf16_t*)(p.ws + WS_OMETA);
    bf16_t* sbt = (bf16_t*)lds; bf16_t* vs = (bf16_t*)(lds + 67584);
    const unsigned vs_base = (unsigned)(size_t)(LAS unsigned char*)(lds + 67584);
    for (int u = opaque_bid(); u < 256; u += opaque_gdim()) {
        const int xcd = u & 7, ix = u >> 3, bh = xcd * 4 + (ix >> 3), vsi = ix & 7, b = bh >> 2, hd = bh & 3, colv = hd * 512 + vsi * 64;
        f32x16 S0, S1;
#pragma unroll
        for (int i = 0; i < 16; ++i) { S0[i] = 0.f; S1[i] = 0.f; }
        for (int i = tid; i < 33792 / 16; i += 512) *(u32x4*)((unsigned char*)sbt + i * 16) = (u32x4){0u, 0u, 0u, 0u};
        const int vj = tid >> 3, vc8 = (tid & 7) * 8;
        u32x4 vnext = *(const u32x4*)(vb + (size_t)(MREG + vj) * 2048 + colv + vc8);
        for (int c = 0; c < 65; ++c) {
            const int g = (c == 0) ? 512 : b * 64 + (c - 1), row0 = (c == 0) ? MREG : g * 64, ug = g * 4 + hd, cur = c & 1;
            *(u32x4*)(vs + cur * 4608 + vj * 72 + vc8) = vnext;
            __syncthreads();
            if (c + 1 < 65) vnext = *(const u32x4*)(vb + (size_t)((b * 64 + c) * 64 + vj) * 2048 + colv + vc8);
            const int ib = wave >> 1, cb0 = 2 * (wave & 1), i = 16 * ib + l15;
            const unsigned vao = vs_base + (unsigned)(cur * 9216 + (8 * l4 + (l15 >> 2)) * 144 + 2 * (16 * cb0 + 4 * (l15 & 3)));
            const unsigned vau = vs_base + (unsigned)(cur * 9216 + (8 * hi + (l15 >> 2)) * 144 + 2 * (16 * ((lane >> 4) & 1) + 4 * (l15 & 3)));
            s16x4 ol[2][2], oh[2][2], ul0[4], uh0[4], ul1[4], uh1[4];
#pragma unroll
            for (int cc = 0; cc < 2; ++cc)
#pragma unroll
                for (int s = 0; s < 2; ++s) { ol[cc][s] = tr_read0(vao + cc * 32 + s * 32 * 144); oh[cc][s] = tr_read0(vao + cc * 32 + s * 32 * 144 + 4 * 144); }
#pragma unroll
            for (int s = 0; s < 2; ++s) {
                ul0[s] = tr_read0(vau + s * 16 * 144); uh0[s] = tr_read0(vau + s * 16 * 144 + 4 * 144);
                ul1[s] = tr_read0(vau + s * 16 * 144 + 64); uh1[s] = tr_read0(vau + s * 16 * 144 + 4 * 144 + 64);
            }
            {
                const bf16_t* ap = attn + (size_t)ug * 4096 + (ib * 2 * 64 + lane) * 8;
                bf16x8 at[2], aq[8];
#pragma unroll
                for (int s = 0; s < 2; ++s) at[s] = *(const bf16x8*)(ap + s * 512);
#pragma unroll
                for (int s = 0; s < 8; ++s) { const int ob = ((ib * 8 + s) * 64 + lane) * 16; aq[s] = *(const bf16x8*)(qb + (size_t)(row0 + (ob >> 9)) * 1024 + hd * 256 + ((ob & 511) >> 1)); }
                asm volatile("s_waitcnt lgkmcnt(8)" ::: "memory"); __builtin_amdgcn_sched_barrier(0);
                f32x4 oacc[2];
#pragma unroll
                for (int cc = 0; cc < 2; ++cc) {
                    const int cb = cb0 + cc; oacc[cc] = (f32x4){0.f, 0.f, 0.f, 0.f};
#pragma unroll
                    for (int s = 0; s < 2; ++s) oacc[cc] = MFMA16(PK8(ol[cc][s], oh[cc][s]), at[s], oacc[cc]);
                    const bf16_t* sp = sbt + cur * 16896 + (16 * cb + l15) * 264 + 8 * l4;
#pragma unroll
                    for (int s = 0; s < 8; ++s) { const bf16x8 bfr = *(const bf16x8*)(sp + 32 * s); oacc[cc] = MFMA16(bfr, aq[s], oacc[cc]); }
                }
#pragma unroll
                for (int s = 2; s < 4; ++s) {
                    ul0[s] = tr_read0(vau + s * 16 * 144); uh0[s] = tr_read0(vau + s * 16 * 144 + 4 * 144);
                    ul1[s] = tr_read0(vau + s * 16 * 144 + 64); uh1[s] = tr_read0(vau + s * 16 * 144 + 4 * 144 + 64);
                }
#pragma unroll
                for (int cc = 0; cc < 2; ++cc) {
                    const int col = colv + 16 * (cb0 + cc) + 4 * l4;
                    u32x2 w; w.x = cvt_pk_bf16(oacc[cc][0], oacc[cc][1]); w.y = cvt_pk_bf16(oacc[cc][2], oacc[cc][3]);
                    if (dry) {} else if (c > 0) *(u32x2*)(vb + (size_t)(row0 + i) * 2048 + col) = w;
                    else if (b == 0 && i < 16) *(u32x2*)(ometa + (size_t)i * 2048 + col) = w;
                }
            }
            {
                const bf16_t* kp = khT + (size_t)ug * 16384 + (wave * 4 * 64 + lane) * 8;
                bf16x8 kt[4];
#pragma unroll
                for (int s = 0; s < 4; ++s) kt[s] = *(const bf16x8*)(kp + s * 512);
                const float* ep = Eo + (size_t)ug * 256 + 32 * wave + 4 * hi;
#pragma unroll
                for (int g4 = 0; g4 < 4; ++g4) { const f32x4 ev = *(const f32x4*)(ep + 8 * g4);
#pragma unroll
                    for (int j = 0; j < 4; ++j) { S0[4 * g4 + j] *= ev[j]; S1[4 * g4 + j] *= ev[j]; } }
                asm volatile("s_waitcnt lgkmcnt(0)" ::: "memory"); __builtin_amdgcn_sched_barrier(0);
#pragma unroll
                for (int s = 0; s < 4; ++s) {
                    S0 = MFMA32(kt[s], PK8(ul0[s], uh0[s]), S0);
                    S1 = MFMA32(kt[s], PK8(ul1[s], uh1[s]), S1);
                }
                bf16_t* wp = sbt + (cur ^ 1) * 16896 + r32 * 264 + 32 * wave + 4 * hi;
#pragma unroll
                for (int g4 = 0; g4 < 4; ++g4) {
                    u32x2 w0; w0.x = cvt_pk_bf16(S0[4 * g4], S0[4 * g4 + 1]); w0.y = cvt_pk_bf16(S0[4 * g4 + 2], S0[4 * g4 + 3]);
                    u32x2 w1; w1.x = cvt_pk_bf16(S1[4 * g4], S1[4 * g4 + 1]); w1.y = cvt_pk_bf16(S1[4 * g4 + 2], S1[4 * g4 + 3]);
                    *(u32x2*)(wp + 8 * g4) = w0; *(u32x2*)(wp + 32 * 264 + 8 * g4) = w1;
                }
            }
        }
        __syncthreads();
    }
}

DI void phase_gate(int wid0, const Params& p, int L, bool dry) {
    const int tid_ = opaque_tid(wid0), lane = tid_ & 63, gw = opaque_bid() * 8 + (tid_ >> 6), nw = opaque_gdim() * 8;
    bf16_t* act = (bf16_t*)(p.ws + WS_ACT); const bf16_t* vb = act + RALLOC * 2048; bf16_t* zb = act + RALLOC * 4096; const bf16_t* ometa = (const bf16_t*)(p.ws + WS_OMETA);
    const float* gn = p.gla_gn + (size_t)(L >> 1) * 2048;
    for (int t = gw; t < (MREG + 16) * 4; t += nw) {
        const int row = t >> 2, hd = t & 3;
        const bf16_t* op = row < MREG ? vb + (size_t)row * 2048 + hd * 512 + lane * 8 : ometa + (size_t)(row - MREG) * 2048 + hd * 512 + lane * 8;
        bf16_t* zp = zb + (size_t)row * 2048 + hd * 512 + lane * 8;
        const bf16x8 ov = *(const bf16x8*)op; const bf16x8 zv = *(const bf16x8*)zp;
        float of[8], ss = 0.f;
#pragma unroll
        for (int e = 0; e < 8; ++e) { of[e] = bf2f(ov[e]); ss += of[e] * of[e]; }
        ss = wave_sum(ss);
        const float rstd = rsqrtf(ss * (1.f / 512.f) + 1e-6f);
        const f32x4 g0 = *(const f32x4*)(gn + hd * 512 + lane * 8), g1 = *(const f32x4*)(gn + hd * 512 + lane * 8 + 4);
        float y[8];
#pragma unroll
        for (int e = 0; e < 8; ++e) { const float z = bf2f(zv[e]); y[e] = z / (1.f + __expf(-z)) * of[e] * rstd * (e < 4 ? g0[e] : g1[e - 4]); }
        u32x4 w; w.x = cvt_pk_bf16(y[0], y[1]); w.y = cvt_pk_bf16(y[2], y[3]); w.z = cvt_pk_bf16(y[4], y[5]); w.w = cvt_pk_bf16(y[6], y[7]);
        if (!dry) *(u32x4*)zp = w;
    }
}

constexpr float ATT_C = 0.088388347648318440f * 1.4426950408889634f;
constexpr float ATT_THR2 = 8.f * 1.4426950408889634f;
#define KSWZ(row, colB) ((row) * 256 + ((colB) ^ (((row) & 7) << 4)))
DI int v_rd_base(int lane) { return ((lane & 3) << 3) | (((lane >> 2) & 3) << 6) | (((lane >> 4) & 1) << 5) | (((lane >> 5) & 1) << 8); }
constexpr int v_rd_off(int d0, int ks, int half) { return d0 * 512 + ks * 8192 + half * 4096; }
template <int OFF> DI s16x4 tr_read(int vb) { s16x4 r; asm volatile("ds_read_b64_tr_b16 %0, %1 offset:%2" : "=&v"(r) : "v"(vb), "i"(OFF) : "memory"); return r; }
template <int D0> DI void pv_two(f32x16& oa, f32x16& ob, int vb, bf16x8 pa0, bf16x8 pa1) {
    const s16x4 l0 = tr_read<v_rd_off(D0, 0, 0)>(vb), h0 = tr_read<v_rd_off(D0, 0, 1)>(vb), l1 = tr_read<v_rd_off(D0, 1, 0)>(vb), h1 = tr_read<v_rd_off(D0, 1, 1)>(vb);
    const s16x4 l2 = tr_read<v_rd_off(D0 + 1, 0, 0)>(vb), h2 = tr_read<v_rd_off(D0 + 1, 0, 1)>(vb), l3 = tr_read<v_rd_off(D0 + 1, 1, 0)>(vb), h3 = tr_read<v_rd_off(D0 + 1, 1, 1)>(vb);
    asm volatile("s_waitcnt lgkmcnt(0)" ::: "memory"); __builtin_amdgcn_sched_barrier(0);
    oa = MFMA32(pa0, PK8(l0, h0), oa);
    ob = MFMA32(pa0, PK8(l2, h2), ob);
    oa = MFMA32(pa1, PK8(l1, h1), oa);
    ob = MFMA32(pa1, PK8(l3, h3), ob);
    __builtin_amdgcn_sched_barrier(0);
}
DI void attn_stage(const bf16_t* kbase, const bf16_t* vbase, unsigned koff, unsigned voff, LAS unsigned char* ldsbuf, int wid) {
#pragma unroll
    for (int i = 0; i < 2; ++i) {
        const char* src = (const char*)kbase + (size_t)(i * 128) * 2;
        __builtin_amdgcn_global_load_lds((const unsigned*)(src + koff), (LAS unsigned*)(ldsbuf + (wid + 8 * i) * 1024), 16, 0, 0);
    }
#pragma unroll
    for (int i = 0; i < 2; ++i) {
        const char* src = (const char*)vbase + (size_t)(16 * i * 2048) * 2;
        __builtin_amdgcn_global_load_lds((const unsigned*)(src + voff), (LAS unsigned*)(ldsbuf + 16384 + (wid + 8 * i) * 1024), 16, 0, 0);
    }
}
DI void finalize_attn(const Params& p, unsigned char* lds, f32x16 (&o)[8], float l_reg, int lane_k, int wid, bool meta, int qrow0, int hh, int di, float lambda_init, bool dry) {
    int lane = (lane_k < 0) ? hw_lane() : lane_k; asm volatile("" : "+v"(lane));
    const int r32 = lane & 31, hi = lane >> 5, rg = wid & 3, psub = wid >> 2;
    float* wsx = (float*)(lds + 132096) + wid * 64; float* li_l = wsx; const float* misc = (const float*)(lds + 134144);
    float* X = (float*)lds; bf16_t* qbuf = (bf16_t*)(p.ws + WS_ACT);
    if (hi == 0) li_l[r32] = l_reg;
    asm volatile("s_waitcnt lgkmcnt(0)" ::: "memory");
    {
        const float sc = psub ? -misc[0] : 1.f;
#pragma unroll
        for (int r = 0; r < 16; ++r) {
            const float c = sc / li_l[crow(r, hi)];
#pragma unroll
            for (int d = 0; d < 8; ++d) o[d][r] *= c;
        }
    }
    __syncthreads();
    if (psub == 1) {
#pragma unroll
        for (int d = 0; d < 8; ++d)
#pragma unroll
            for (int r = 0; r < 16; ++r) X[(rg * 128 + d * 16 + r) * 64 + lane] = o[d][r];
    }
    __syncthreads();
    if (psub == 0) {
#pragma unroll
        for (int d = 0; d < 8; ++d)
#pragma unroll
            for (int r = 0; r < 16; ++r) o[d][r] += X[(rg * 128 + d * 16 + r) * 64 + lane];
        asm volatile("s_waitcnt lgkmcnt(0)" ::: "memory");
        float* R = (float*)(lds + rg * 32768);
#pragma unroll
        for (int d = 0; d < 8; ++d)
#pragma unroll
            for (int r = 0; r < 16; ++r) R[crow(r, hi) * 256 + 32 * d + r32] = o[d][r];
        asm volatile("s_waitcnt lgkmcnt(0)" ::: "memory");
        const float og = 1.f - misc[1]; const int c8 = (lane & 31) * 8;
        const f32x4 g0 = *(const f32x4*)(p.diff_gn + (size_t)di * 256 + c8) * og, g1 = *(const f32x4*)(p.diff_gn + (size_t)di * 256 + c8 + 4) * og;
        bf16_t* dstb = qbuf + (size_t)(qrow0 + 32 * rg + (lane >> 5)) * 2048 + hh * 256 + c8;
        const int nrow = dry ? 0 : (meta ? (rg == 0 ? 16 : 0) : 32);
#pragma unroll 2
        for (int it = 0; it < 16; ++it) {
            const int row = 2 * it + (lane >> 5);
            f32x4 a = *(const f32x4*)(R + row * 256 + c8), b = *(const f32x4*)(R + row * 256 + c8 + 4);
            float ss = a[0] * a[0] + a[1] * a[1] + a[2] * a[2] + a[3] * a[3] + b[0] * b[0] + b[1] * b[1] + b[2] * b[2] + b[3] * b[3];
            ss = half_sum(ss);
            const float rstd = rsqrtf(ss * (1.f / 256.f) + 1e-6f);
            a = a * rstd * g0; b = b * rstd * g1;
            u32x4 w; w.x = cvt_pk_bf16(a[0], a[1]); w.y = cvt_pk_bf16(a[2], a[3]); w.z = cvt_pk_bf16(b[0], b[1]); w.w = cvt_pk_bf16(b[2], b[3]);
            if (row < nrow) *(u32x4*)(dstb + (size_t)it * 4096) = w;
        }
    }
}
DI void phase_attn(int wid0, const Params& p, int L, unsigned char* lds, bool dry) {
    const int di = L >> 1; const float lambda_init = 0.8f - 0.6f * __expf(-0.3f * (float)L);
    const int tid = opaque_tid(wid0), wid = __builtin_amdgcn_readfirstlane(tid >> 6), lane_k = tid & 63, rg = wid & 3, psub = wid >> 2;
    LAS unsigned char* ldsl = (LAS unsigned char*)lds;
    float* tab = (float*)(lds + 131072); float* wsx = (float*)(lds + 132096) + wid * 64; float* li_l = wsx; float* al_l = wsx + 32; float* misc = (float*)(lds + 134144);
    float* X = (float*)lds;
    bf16_t* act = (bf16_t*)(p.ws + WS_ACT); bf16_t* qbuf = act; const bf16_t* kbuf = act + RALLOC * 2048; const bf16_t* vbuf = act + RALLOC * 4096;
    const float* biasT = (const float*)(p.ws + WS_BIAS);
    if (wid == 0) {
        const float* lv = p.diff_lam + (size_t)di * 512;
        const int lane = lane_k; float s1 = lv[lane] * lv[128 + lane] + lv[64 + lane] * lv[192 + lane], s2 = lv[256 + lane] * lv[384 + lane] + lv[320 + lane] * lv[448 + lane];
        s1 = wave_sum(s1); s2 = wave_sum(s2);
        if (lane == 0) { misc[0] = __expf(s1) - __expf(s2) + lambda_init; misc[1] = lambda_init; }
    }
    __syncthreads();
    const int G = opaque_gdim(), blk = opaque_bid();
    for (int ui = 0;; ++ui) {
        int b, hh, qb; bool meta = false;
        int lane = lane_k; asm volatile("" : "+v"(lane));
        const int r32 = lane & 31, hi = lane >> 5;
        unsigned koff, voff;
        { const int row = 4 * wid + (lane >> 4), gsrc = (lane & 15) ^ (row & 7); koff = (unsigned)(row * 2048 + 8 * gsrc) * 2u;
          const int w5 = (lane & 31) >> 2, kl = (w5 & 3) + 8 * (w5 >> 2) + 4 * (wid >> 2), col = ((2 * wid + (lane >> 5)) & 7) * 32 + (lane & 3) * 8; voff = (unsigned)(kl * 2048 + col) * 2u; }

        if (G == 256) {
            if (ui < 8) { const int bh = 8 * ui + (blk & 7), j = blk >> 3; qb = (ui & 1) ? 31 - j : j; b = bh >> 3; hh = bh & 7; }
            else if (ui == 8 && blk < 8) { meta = true; hh = blk; b = 0; qb = 0; }
            else break;
        } else {
            const int u = blk + ui * G;
            if (u < 2048) { const int bh = u & 63; qb = 31 - (u >> 6); b = bh >> 3; hh = bh & 7; }
            else if (u < 2056) { meta = true; hh = u - 2048; b = 0; qb = 0; }
            else break;
        }
        const int qrow0 = meta ? MREG : b * 4096 + 128 * qb, qpos0 = meta ? 0 : 16 + 128 * qb, ntiles = meta ? 1 : 1 + 4 * (qb + 1);
        if (tid < 130) tab[tid] = (tid < 129) ? biasT[hh * 129 + tid] : -__builtin_inff();
        int myrow = qrow0 + 32 * rg + r32; if (meta && myrow > MREG + 63) myrow = MREG + 63;
        const bf16_t* qp = qbuf + (size_t)myrow * 2048 + hh * 256 + psub * 128 + hi * 8;
        unsigned char* qlds = lds + wid * 8192 + lane * 16;
#pragma unroll
        for (int d0 = 0; d0 < 8; ++d0) *(bf16x8*)(qlds + d0 * 1024) = *(const bf16x8*)(qp + d0 * 16);
        const int wq0 = qpos0 + 32 * rg, qpos = wq0 + r32;
        const bf16_t* kh_ = kbuf + hh * 256; const bf16_t* vh_ = vbuf + hh * 256;
        attn_stage(kh_ + (size_t)MREG * 2048, vh_ + (size_t)MREG * 2048, koff, voff, ldsl + 65536, wid);
        f32x16 o[8];
#pragma unroll
        for (int d = 0; d < 8; ++d)
#pragma unroll
            for (int r = 0; r < 16; ++r) o[d][r] = 0.f;
        float m_reg = -1e30f, l_reg = 0.f;
        for (int t = 0; t < ntiles; ++t) {
            asm volatile("s_waitcnt vmcnt(0) lgkmcnt(0)" ::: "memory"); __builtin_amdgcn_s_barrier(); asm volatile("" ::: "memory");
            if (t + 1 < ntiles) attn_stage(kh_ + (size_t)(b * 4096 + 32 * t) * 2048, vh_ + (size_t)(b * 4096 + 32 * t) * 2048, koff, voff, ldsl + 65536 + ((t + 1) & 1) * 32768, wid);
            const int kpos0 = (t == 0) ? 0 : 16 + 32 * (t - 1);
            if (kpos0 <= wq0 + 31) {
                const unsigned char* Ks = lds + 65536 + (t & 1) * 32768 + psub * 8192;
                f32x16 p0, p0b;
#pragma unroll
                for (int r = 0; r < 16; ++r) { p0[r] = 0.f; p0b[r] = 0.f; }
                int swz = (r32 & 6) << 4, kro = r32 * 256 + ((hi ^ (r32 & 1)) << 4); asm volatile("" : "+v"(swz), "+v"(kro));
#pragma unroll
                for (int d0 = 0; d0 < 8; d0 += 2) {
                    const bf16x8 b0 = *(const bf16x8*)(Ks + kro + ((d0 * 32) ^ swz));
                    const bf16x8 qf = *(const bf16x8*)(qlds + d0 * 1024);
                    const bf16x8 b1 = *(const bf16x8*)(Ks + kro + (((d0 + 1) * 32) ^ swz));
                    const bf16x8 qg = *(const bf16x8*)(qlds + (d0 + 1) * 1024);
                    p0 = MFMA32(b0, qf, p0);
                    p0b = MFMA32(b1, qg, p0b);
                    if (d0 == 2) __builtin_amdgcn_sched_barrier(0);
                }
#pragma unroll
                for (int r = 0; r < 16; ++r) p0[r] += p0b[r];
                __builtin_amdgcn_sched_barrier(0);
                if (t > 0 && wq0 - (kpos0 + 31) >= 128) {
                    const float bfar = tab[128];
#pragma unroll
                    for (int r = 0; r < 16; ++r) p0[r] = fmaf(p0[r], ATT_C, bfar);
                } else {
#pragma unroll
                    for (int r = 0; r < 16; ++r) {
                        const int k0i = crow(r, hi);
                        const int d0v = qpos - (kpos0 + k0i);
                        const bool v0 = (d0v >= 0) && (t > 0 || k0i < 16);
                        const int idx = v0 ? (d0v < 128 ? d0v : 128) : 129;
                        p0[r] = fmaf(p0[r], ATT_C, tab[idx]);
                        if ((r & 3) == 3) __builtin_amdgcn_sched_barrier(0);
                    }
                }
                __builtin_amdgcn_sched_barrier(0);
                float pmax = p0[0];
#pragma unroll
                for (int r = 1; r < 16; ++r) pmax = fmaxf(pmax, p0[r]);
                { auto rr = __builtin_amdgcn_permlane32_swap(__float_as_uint(pmax), __float_as_uint(pmax), false, false); pmax = fmaxf(__uint_as_float(rr[0]), __uint_as_float(rr[1])); }
                float mn, alpha;
                if (__all(pmax - m_reg <= ATT_THR2)) { mn = m_reg; alpha = 1.f; }
                else { mn = fmaxf(m_reg, pmax); alpha = __builtin_amdgcn_exp2f(m_reg - mn); m_reg = mn; }
                float ps = 0.f;
#pragma unroll
                for (int r = 0; r < 16; ++r) { p0[r] = __builtin_amdgcn_exp2f(p0[r] - mn); ps += p0[r]; }
                { auto rr = __builtin_amdgcn_permlane32_swap(__float_as_uint(ps), __float_as_uint(ps), false, false); ps = __uint_as_float(rr[0]) + __uint_as_float(rr[1]); }
                l_reg = l_reg * alpha + ps;
                __builtin_amdgcn_sched_barrier(0);
                bf16x8 pa0, pa1;
#define PK4(P, BASE, OUT) do { unsigned a0 = cvt_pk_bf16(P[BASE + 0], P[BASE + 1]), a1 = cvt_pk_bf16(P[BASE + 2], P[BASE + 3]);   \
    unsigned b0_ = cvt_pk_bf16(P[BASE + 4], P[BASE + 5]), b1_ = cvt_pk_bf16(P[BASE + 6], P[BASE + 7]);                              \
    auto r0 = __builtin_amdgcn_permlane32_swap(a0, b0_, false, false); auto r1 = __builtin_amdgcn_permlane32_swap(a1, b1_, false, false); \
    u32x4 w_ = {r0[0], r1[0], r0[1], r1[1]}; OUT = __builtin_bit_cast(bf16x8, w_); } while (0)
                PK4(p0, 0, pa0); PK4(p0, 8, pa1);
#undef PK4
                __builtin_amdgcn_sched_barrier(0);
                if (__any(alpha < 1.f)) {
                    if (hi == 0) al_l[r32] = alpha;
                    asm volatile("s_waitcnt lgkmcnt(0)" ::: "memory");
                    float ar[16];
#pragma unroll
                    for (int r = 0; r < 16; ++r) ar[r] = al_l[crow(r, hi)];
#pragma unroll
                    for (int d = 0; d < 8; ++d)
#pragma unroll
                        for (int r = 0; r < 16; ++r) o[d][r] *= ar[r];
                }
                __builtin_amdgcn_sched_barrier(0);
                LAS unsigned char* vbp = ldsl + 65536 + (t & 1) * 32768 + 16384 + v_rd_base(lane);
                __builtin_amdgcn_s_setprio(1);
#define TRB(OFF) __builtin_amdgcn_ds_read_tr16_b64_v4i16((LAS s16x4*)(vbp + (OFF)))
#define PV_RD(D0, L0, H0, L1, H1) L0 = TRB(v_rd_off(D0, 0, 0)); H0 = TRB(v_rd_off(D0, 0, 1)); L1 = TRB(v_rd_off(D0, 1, 0)); H1 = TRB(v_rd_off(D0, 1, 1))
#define PV_MM(D0, L0, H0, L1, H1) o[D0] = MFMA32(pa0, PK8(L0, H0), o[D0]); o[D0] = MFMA32(pa1, PK8(L1, H1), o[D0])
#define SB() __builtin_amdgcn_sched_barrier(0)
                {
                    s16x4 a0, a1, a2, a3, b0_, b1_, b2_, b3_;
                    PV_RD(0, a0, a1, a2, a3); SB();
                    PV_RD(1, b0_, b1_, b2_, b3_); SB(); PV_MM(0, a0, a1, a2, a3); SB();
                    PV_RD(2, a0, a1, a2, a3); SB(); PV_MM(1, b0_, b1_, b2_, b3_); SB();
                    PV_RD(3, b0_, b1_, b2_, b3_); SB(); PV_MM(2, a0, a1, a2, a3); SB();
                    PV_RD(4, a0, a1, a2, a3); SB(); PV_MM(3, b0_, b1_, b2_, b3_); SB();
                    PV_RD(5, b0_, b1_, b2_, b3_); SB(); PV_MM(4, a0, a1, a2, a3); SB();
                    PV_RD(6, a0, a1, a2, a3); SB(); PV_MM(5, b0_, b1_, b2_, b3_); SB();
                    PV_RD(7, b0_, b1_, b2_, b3_); SB(); PV_MM(6, a0, a1, a2, a3); SB();
                    PV_MM(7, b0_, b1_, b2_, b3_); SB();
                }
#undef TRB
#undef PV_RD
#undef PV_MM
#undef SB
                __builtin_amdgcn_s_setprio(0);
            }
        }
        finalize_attn(p, lds, o, l_reg, lane_k, wid, meta, qrow0, hh, di, lambda_init, dry);
        __syncthreads();
    }
}


DI void attn_stage64(const bf16_t* kbase, const bf16_t* vbase, unsigned koff, unsigned voff, LAS unsigned char* ldsbuf, int wid) {
#pragma unroll
    for (int i = 0; i < 4; ++i) {
        const unsigned off = koff + (unsigned)((32 * (i & 1)) * 2048 + (i >> 1) * 128) * 2u;
        __builtin_amdgcn_global_load_lds((const unsigned*)((const char*)kbase + off), (LAS unsigned*)(ldsbuf + (wid + 8 * i) * 1024), 16, 0, 0);
    }
#pragma unroll
    for (int i = 0; i < 4; ++i) {
        const unsigned off = voff + (unsigned)(16 * i * 2048) * 2u;
        __builtin_amdgcn_global_load_lds((const unsigned*)((const char*)vbase + off), (LAS unsigned*)(ldsbuf + 32768 + (wid + 8 * i) * 1024), 16, 0, 0);
    }
}
template <int D0, int KH> DI void pv_two64(f32x16& oa, f32x16& ob, int vb, bf16x8 pa0, bf16x8 pa1) {
    const s16x4 l0 = tr_read<v_rd_off(D0, 2 * KH, 0)>(vb), h0 = tr_read<v_rd_off(D0, 2 * KH, 1)>(vb), l1 = tr_read<v_rd_off(D0, 2 * KH + 1, 0)>(vb), h1 = tr_read<v_rd_off(D0, 2 * KH + 1, 1)>(vb);
    const s16x4 l2 = tr_read<v_rd_off(D0 + 1, 2 * KH, 0)>(vb), h2 = tr_read<v_rd_off(D0 + 1, 2 * KH, 1)>(vb), l3 = tr_read<v_rd_off(D0 + 1, 2 * KH + 1, 0)>(vb), h3 = tr_read<v_rd_off(D0 + 1, 2 * KH + 1, 1)>(vb);
    asm volatile("s_waitcnt lgkmcnt(0)" ::: "memory"); __builtin_amdgcn_sched_barrier(0);
    oa = MFMA32(pa0, PK8(l0, h0), oa);
    ob = MFMA32(pa0, PK8(l2, h2), ob);
    oa = MFMA32(pa1, PK8(l1, h1), oa);
    ob = MFMA32(pa1, PK8(l3, h3), ob);
    __builtin_amdgcn_sched_barrier(0);
}
template <int KH> DI void attn_half(f32x16 (&o)[8], const bf16x8 (&qr)[8], float& m_reg, float& l_reg, const unsigned char* Ks, int vb0, const float* tab, float* al_l,
                                    int r32, int hi, int qpos, int wq0, int kpos0, bool t0) {
    if (kpos0 > wq0 + 31) return;
    f32x16 p0;
#pragma unroll
    for (int r = 0; r < 16; ++r) p0[r] = 0.f;
    int swz = (r32 & 6) << 4, kro = (32 * KH + r32) * 256 + ((hi ^ (r32 & 1)) << 4); asm volatile("" : "+v"(swz), "+v"(kro));
#pragma unroll
    for (int d0 = 0; d0 < 8; ++d0) {
        const bf16x8 b0 = *(const bf16x8*)(Ks + kro + ((d0 * 32) ^ swz));
        p0 = MFMA32(b0, qr[d0], p0);
        if (d0 == 3) __builtin_amdgcn_sched_barrier(0);
    }
    __builtin_amdgcn_sched_barrier(0);
    if (!t0 && wq0 - (kpos0 + 31) >= 128) {
        const float bfar = tab[128];
#pragma unroll
        for (int r = 0; r < 16; ++r) p0[r] = fmaf(p0[r], ATT_C, bfar);
    } else {
#pragma unroll
        for (int r = 0; r < 16; ++r) {
            const int k0i = crow(r, hi);
            const int d0v = qpos - (kpos0 + k0i);
            const bool v0 = (d0v >= 0) && (!t0 || k0i < 16);
            const int idx = v0 ? (d0v < 128 ? d0v : 128) : 129;
            p0[r] = fmaf(p0[r], ATT_C, tab[idx]);
            if ((r & 3) == 3) __builtin_amdgcn_sched_barrier(0);
        }
    }
    __builtin_amdgcn_sched_barrier(0);
    float pmax = p0[0];
#pragma unroll
    for (int r = 1; r < 16; ++r) pmax = fmaxf(pmax, p0[r]);
    { auto rr = __builtin_amdgcn_permlane32_swap(__float_as_uint(pmax), __float_as_uint(pmax), false, false); pmax = fmaxf(__uint_as_float(rr[0]), __uint_as_float(rr[1])); }
    float mn, alpha;
    if (__all(pmax - m_reg <= ATT_THR2)) { mn = m_reg; alpha = 1.f; }
    else { mn = fmaxf(m_reg, pmax); alpha = __builtin_amdgcn_exp2f(m_reg - mn); m_reg = mn; }
    float ps = 0.f;
#pragma unroll
    for (int r = 0; r < 16; ++r) { p0[r] = __builtin_amdgcn_exp2f(p0[r] - mn); ps += p0[r]; }
    { auto rr = __builtin_amdgcn_permlane32_swap(__float_as_uint(ps), __float_as_uint(ps), false, false); ps = __uint_as_float(rr[0]) + __uint_as_float(rr[1]); }
    l_reg = l_reg * alpha + ps;
    __builtin_amdgcn_sched_barrier(0);
    bf16x8 pa0, pa1;
#define PK4(P, BASE, OUT) do { unsigned a0 = cvt_pk_bf16(P[BASE + 0], P[BASE + 1]), a1 = cvt_pk_bf16(P[BASE + 2], P[BASE + 3]);   \
    unsigned b0_ = cvt_pk_bf16(P[BASE + 4], P[BASE + 5]), b1_ = cvt_pk_bf16(P[BASE + 6], P[BASE + 7]);                              \
    auto r0 = __builtin_amdgcn_permlane32_swap(a0, b0_, false, false); auto r1 = __builtin_amdgcn_permlane32_swap(a1, b1_, false, false); \
    u32x4 w_ = {r0[0], r1[0], r0[1], r1[1]}; OUT = __builtin_bit_cast(bf16x8, w_); } while (0)
    PK4(p0, 0, pa0); PK4(p0, 8, pa1);
#undef PK4
    __builtin_amdgcn_sched_barrier(0);
    if (__any(alpha < 1.f)) {
        if (hi == 0) al_l[r32] = alpha;
        asm volatile("s_waitcnt lgkmcnt(0)" ::: "memory");
        float ar[16];
#pragma unroll
        for (int r = 0; r < 16; ++r) ar[r] = al_l[crow(r, hi)];
#pragma unroll
        for (int d = 0; d < 8; ++d)
#pragma unroll
            for (int r = 0; r < 16; ++r) o[d][r] *= ar[r];
    }
    __builtin_amdgcn_sched_barrier(0);
    pv_two64<0, KH>(o[0], o[1], vb0, pa0, pa1); pv_two64<2, KH>(o[2], o[3], vb0, pa0, pa1); pv_two64<4, KH>(o[4], o[5], vb0, pa0, pa1); pv_two64<6, KH>(o[6], o[7], vb0, pa0, pa1);
}
DI void phase_attn64(int wid0, const Params& p, int L, unsigned char* lds, bool dry) {
    const int di = L >> 1; const float lambda_init = 0.8f - 0.6f * __expf(-0.3f * (float)L);
    const int tid = opaque_tid(wid0), wid = __builtin_amdgcn_readfirstlane(tid >> 6), lane_k = tid & 63, rg = wid & 3, psub = wid >> 2;
    LAS unsigned char* ldsl = (LAS unsigned char*)lds;
    float* tab = (float*)(lds + 131072); float* wsx = (float*)(lds + 132096) + wid * 64; float* al_l = wsx + 32; float* misc = (float*)(lds + 134144);
    bf16_t* act = (bf16_t*)(p.ws + WS_ACT); bf16_t* qbuf = act; const bf16_t* kbuf = act + RALLOC * 2048; const bf16_t* vbuf = act + RALLOC * 4096;
    const float* biasT = (const float*)(p.ws + WS_BIAS);
    if (wid == 0) {
        const float* lv = p.diff_lam + (size_t)di * 512;
        const int lane = lane_k; float s1 = lv[lane] * lv[128 + lane] + lv[64 + lane] * lv[192 + lane], s2 = lv[256 + lane] * lv[384 + lane] + lv[320 + lane] * lv[448 + lane];
        s1 = wave_sum(s1); s2 = wave_sum(s2);
        if (lane == 0) { misc[0] = __expf(s1) - __expf(s2) + lambda_init; misc[1] = lambda_init; }
    }
    __syncthreads();
    const int blk = opaque_bid();
    for (int ui = 0;; ++ui) {
        int b, hh, qb; bool meta = false;
        int lane = hw_lane(); asm volatile("" : "+v"(lane));
        const int r32 = lane & 31, hi = lane >> 5;
#define ATT_OFFS(LN) unsigned koff, voff; { int ln_ = (LN); asm volatile("" : "+v"(ln_)); const int row = 4 * wid + (ln_ >> 4), gsrc = (ln_ & 15) ^ (row & 7); koff = (unsigned)(row * 2048 + 8 * gsrc) * 2u; \
          const int w5 = (ln_ & 31) >> 2, kl = (w5 & 3) + 8 * (w5 >> 2) + 4 * (wid >> 2), col = ((2 * wid + (ln_ >> 5)) & 7) * 32 + (ln_ & 3) * 8; voff = (unsigned)(kl * 2048 + col) * 2u; }
        if (ui < 8) { const int bh = 8 * ui + (blk & 7), j = (blk >> 3) & 31; qb = (ui & 1) ? 31 - j : j; b = bh >> 3; hh = bh & 7; }
        else if (ui == 8 && blk < 8) { meta = true; hh = blk; b = 0; qb = 0; }
        else break;
        const int qrow0 = meta ? MREG : b * 4096 + 128 * qb, qpos0 = meta ? 0 : 16 + 128 * qb, ntiles = meta ? 1 : 1 + 2 * (qb + 1);
        { const int t_ = wid * 64 + lane; if (t_ < 130) tab[t_] = (t_ < 129) ? biasT[hh * 129 + t_] : -__builtin_inff(); }
        __builtin_amdgcn_sched_barrier(0);
        int myrow = qrow0 + 32 * rg + r32; if (meta && myrow > MREG + 63) myrow = MREG + 63;
        const bf16_t* qp = qbuf + (size_t)myrow * 2048 + hh * 256 + psub * 128 + hi * 8;
        bf16x8 qr[8];
#pragma unroll
        for (int d0 = 0; d0 < 8; ++d0) qr[d0] = *(const bf16x8*)(qp + d0 * 16);
        __builtin_amdgcn_sched_barrier(0);
        const int wq0 = qpos0 + 32 * rg, qpos = wq0 + r32;
        const bf16_t* kh_ = kbuf + hh * 256; const bf16_t* vh_ = vbuf + hh * 256;
        { ATT_OFFS(lane); attn_stage64(kh_ + (size_t)MREG * 2048, vh_ + (size_t)MREG * 2048, koff, voff, ldsl, wid); }
        __builtin_amdgcn_sched_barrier(0);
        f32x16 o[8];
#pragma unroll
        for (int d = 0; d < 8; ++d)
#pragma unroll
            for (int r = 0; r < 16; ++r) o[d][r] = 0.f;
        float m_reg = -1e30f, l_reg = 0.f;
        for (int t = 0; t < ntiles; ++t) {
            asm volatile("s_waitcnt vmcnt(0) lgkmcnt(0)" ::: "memory"); __builtin_amdgcn_s_barrier(); asm volatile("" ::: "memory");
            if (t + 1 < ntiles) { ATT_OFFS(lane); attn_stage64(kh_ + (size_t)(b * 4096 + 64 * t) * 2048, vh_ + (size_t)(b * 4096 + 64 * t) * 2048, koff, voff, ldsl + ((t + 1) & 1) * 65536, wid); }
            const int kpos0 = (t == 0) ? 0 : 16 + 64 * (t - 1);
            const unsigned char* Ks = lds + (t & 1) * 65536 + psub * 16384;
            const int vb0 = (int)(unsigned)(size_t)(ldsl + (t & 1) * 65536 + 32768) + v_rd_base(lane);
            attn_half<0>(o, qr, m_reg, l_reg, Ks, vb0, tab, al_l, r32, hi, qpos, wq0, kpos0, t == 0);
            if (t > 0) attn_half<1>(o, qr, m_reg, l_reg, Ks, vb0, tab, al_l, r32, hi, qpos, wq0, kpos0 + 32, false);
        }
        finalize_attn(p, lds, o, l_reg, -1, wid, meta, qrow0, hh, di, lambda_init, dry);
        __syncthreads();
    }
}

#define XB_TMO      128
#define XB_XCNT(j)  (256  + 64 * (j))
#define XB_XSUB(j)  (1280 + 64 * (j))
#define XB_XGEN(j)  (2304 + 64 * (j))
#define XB_TOP      3328
#define XB_TOPGEN   3392
#define XCD_BAR_WORDS 3456
#define XB_SPIN_CAP (1u << 22)
DI unsigned xb_ld(unsigned* p)              { return __hip_atomic_load(p, __ATOMIC_RELAXED, __HIP_MEMORY_SCOPE_AGENT); }
DI unsigned xb_add(unsigned* p, unsigned v) { return __hip_atomic_fetch_add(p, v, __ATOMIC_RELAXED, __HIP_MEMORY_SCOPE_AGENT); }
DI unsigned xb_xcc_id() { return (unsigned)__builtin_amdgcn_s_getreg((3 << 11) | 20) & 0xFu; }
#define XB_SPIN(cond, bar) do { unsigned _sp = 0; while (cond) { __builtin_amdgcn_s_sleep(1); \
    if ((++_sp & 255u) == 0u) { if (xb_ld(&(bar)[XB_TMO])) break; if (_sp > XB_SPIN_CAP) { atomicAdd(&(bar)[XB_TMO], 1u); break; } } } } while (0)
struct XcdBarrier { unsigned* bar; unsigned x; volatile LAS unsigned* st; };
DI XcdBarrier xcd_barrier_post(int wid0, unsigned* bar, volatile LAS unsigned* st) {
    XcdBarrier b; b.bar = bar; b.x = xb_xcc_id(); b.st = st;
    if (wid0 == 0 && hw_lane() == 0) (void)xb_add(&bar[XB_XCNT(b.x)], 1u);
    return b;
}
DI void xcd_barrier_complete(unsigned* bar, unsigned x, unsigned& nloc, unsigned& nx) {
    const unsigned G = (unsigned)opaque_gdim();
    unsigned sum, cnt, mine, sp = 0u;
    for (;;) {
        sum = 0u; cnt = 0u; mine = 0u;
#pragma unroll
        for (unsigned j = 0; j < 16; ++j) { const unsigned c = xb_ld(&bar[XB_XCNT(j)]); sum += c; cnt += (c > 0u) ? 1u : 0u; mine = (j == x) ? c : mine; }
        if (sum == G) break;
        __builtin_amdgcn_s_sleep(1);
        if ((++sp & 255u) == 0u) { if (xb_ld(&bar[XB_TMO])) break; if (sp > XB_SPIN_CAP) { atomicAdd(&bar[XB_TMO], 1u); break; } }
    }
    nloc = mine > 0u ? mine : 1u; nx = cnt > 0u ? cnt : 1u;
}
DI void xcd_barrier(int wid0, const XcdBarrier& b) {
    asm volatile("s_waitcnt vmcnt(0)" ::: "memory");
    __syncthreads();
    if (wid0 == 0 && hw_lane() == 0) {
        unsigned* bar = b.bar;
        __builtin_amdgcn_s_waitcnt(0);
        unsigned nloc = b.st[0], nx = b.st[1];
        if (nloc == 0u) { xcd_barrier_complete(bar, b.x, nloc, nx); b.st[0] = nloc; b.st[1] = nx; }
        const unsigned old = xb_add(&bar[XB_XSUB(b.x)], 1u);
        const unsigned gen = old / nloc;
        if (old + 1u == (gen + 1u) * nloc) {
            __builtin_amdgcn_fence(__ATOMIC_RELEASE, "agent");
            asm volatile("s_waitcnt vmcnt(0)" ::: "memory");
            const unsigned og = xb_add(&bar[XB_TOP], 1u);
            const unsigned tg = og / nx;
            if (og + 1u == (tg + 1u) * nx) xb_add(&bar[XB_TOPGEN], 1u);
            else XB_SPIN(xb_ld(&bar[XB_TOPGEN]) == tg, bar);
            __builtin_amdgcn_fence(__ATOMIC_ACQUIRE, "agent");
            xb_add(&bar[XB_XGEN(b.x)], 1u);
            asm volatile("s_waitcnt vmcnt(0)" ::: "memory");
        } else {
            XB_SPIN(xb_ld(&bar[XB_XGEN(b.x)]) == gen, bar);
            __builtin_amdgcn_fence(__ATOMIC_ACQUIRE, "agent");
            asm volatile("s_waitcnt vmcnt(0)" ::: "memory");
        }
    }
    __syncthreads();
}

__global__ void __launch_bounds__(512) mega(Params p_arg) {
    extern __shared__ __attribute__((aligned(16))) unsigned char lds[];
    cg::grid_group grid = cg::this_grid();
    const int ph_lo = p_arg.ph_lo, ph_hi = p_arg.ph_hi;
    if (ph_lo < 0) grid.sync();
    volatile LAS unsigned* xbst = (volatile LAS unsigned*)(LAS unsigned char*)(lds + LDS_BYTES - 16);
    const int wid0 = __builtin_amdgcn_readfirstlane((int)(threadIdx.x >> 6));
    if (wid0 == 0 && hw_lane() == 0) { xbst[0] = 0u; xbst[1] = 0u; }
    __syncthreads();
    XcdBarrier xb; xb.bar = (unsigned*)(p_arg.ws + WS_BAR); xb.x = 0; xb.st = xbst;
    if (ph_hi - ph_lo > 1) xb = xcd_barrier_post(wid0, (unsigned*)(p_arg.ws + WS_BAR), xbst);
    for (int ph = ph_lo; ph < ph_hi; ++ph) {
        const __attribute__((address_space(4))) Params* pp = (const __attribute__((address_space(4))) Params*)__builtin_amdgcn_kernarg_segment_ptr();
        asm volatile("" : "+s"(pp));
        Params p;
        p.x = pp->x; p.meta = pp->meta; p.g_norm = pp->g_norm; p.gla_w_in = pp->gla_w_in; p.gla_wgu = pp->gla_wgu; p.gla_bg = pp->gla_bg; p.gla_gn = pp->gla_gn; p.gla_w_out = pp->gla_w_out;
        p.diff_w_in = pp->diff_w_in; p.diff_lam = pp->diff_lam; p.diff_gn = pp->diff_gn; p.diff_w_out = pp->diff_w_out; p.rel_bias = pp->rel_bias; p.g_final = pp->g_final; p.out = pp->out; p.ws = pp->ws;
        p.ph_lo = ph_lo; p.ph_hi = ph_hi;
        bf16_t* act = (bf16_t*)(p.ws + WS_ACT); const bf16_t* hn = (const bf16_t*)(p.ws + WS_HN);
        const bf16_t* win = (const bf16_t*)(p.ws + WS_WIN); const bf16_t* wout = (const bf16_t*)(p.ws + WS_WOUT); const bf16_t* wg = (const bf16_t*)(p.ws + WS_WG);
        float* hmeta = (float*)(p.ws + WS_HMETA);
        const int G = opaque_gdim(), bid = opaque_bid();
        int L, kind;
        if (ph == 0) { L = 0; kind = 0; }
        else if (ph <= 6) { L = 0; kind = ph; }
        else if (ph <= 11) { L = 1; kind = ph; }
        else if (ph <= 17) { L = 2; kind = ph - 11; }
        else { L = 3; kind = ph - 11; }
        for (int rep = 0; rep < (((DBG_DOUBLE >> kind) & 1) && !(kind == 11 && L == 3) ? 2 : 1); ++rep) {
        if (EN(0) && kind == 0) { phase_bias(wid0, p); phase_norm(wid0, p, 0); phase_wconv(wid0, p, 0, lds); }
        else if (EN(1) && kind == 1) {
            pg8::Gemm g{hn, win, MREG, 6144, 1024}; pg8::StaticOrder S; S.init(MREG, 6144, G, bid);
            pg8::EpiGen<StGlaIn> E{StGlaIn{act}};
            pg8::gemm_phase(wid0, (LAS unsigned char*)lds, g, S, E);
            mini_gemm(wid0, hn, 1024, MREG, 4, win, 1024, 6144, StGlaIn{act});
            glr_gemm(wid0, hn, wg, (float*)(p.ws + WS_GLR));
        }
        else if (EN(2) && kind == 2) phase_prep(wid0, p, L, lds, DRY(rep));
        else if (EN(3) && kind == 3) phase_scan(wid0, p, lds, DRY(rep));
        else if (EN(4) && kind == 4) phase_gate(wid0, p, L, DRY(rep));
        else if (EN(5) && (kind == 5 || kind == 10)) {
            const bf16_t* A = (kind == 5) ? act + RALLOC * 4096 : act;
            const float* hsrc = (L == 0) ? p.x : p.out; const float* msrc = (L == 0) ? p.meta : hmeta;
            pg8::Gemm g{A, wout, MREG, 1024, 2048}; pg8::StaticOrder S; S.init(MREG, 1024, G, bid);
            pg8::EpiGen<StResid> E{StResid{hsrc, p.out, 0, DRY(rep)}};
            pg8::gemm_phase(wid0, (LAS unsigned char*)lds, g, S, E);
            mini_gemm(wid0, A, 2048, MREG, 1, wout, 2048, 1024, StResid{msrc, hmeta, MREG, DRY(rep)});
        }
        else if (EN(6) && (kind == 6 || kind == 11)) {
            if (L == 3) phase_final(wid0, p);
            else { phase_norm(wid0, p, L + 1); phase_wconv(wid0, p, L + 1, lds); }
        }
        else if (EN(7) && kind == 7) {
            pg8::Gemm g{hn, win, MREG, 6144, 1024}; pg8::StaticOrder S; S.init(MREG, 6144, G, bid);
            pg8::EpiGen<StDiffIn> E{StDiffIn{act}};
            pg8::gemm_phase(wid0, (LAS unsigned char*)lds, g, S, E);
            mini_gemm(wid0, hn, 1024, MREG, 4, win, 1024, 6144, StDiffIn{act});
        }
        else if (EN(8) && kind == 8) phase_attn(wid0, p, L, lds, DRY(rep));
        else if (EN(9) && kind == 9) {
            pg8::Gemm g{hn, win + (size_t)6144 * 1024, MREG, 2048, 1024}; pg8::StaticOrder S; S.init(MREG, 2048, G, bid);
            pg8::EpiGen<StZGate> E{StZGate{act, DRY(rep)}};
            pg8::gemm_phase(wid0, (LAS unsigned char*)lds, g, S, E);
            mini_gemm(wid0, hn, 1024, MREG, 1, win + (size_t)6144 * 1024, 1024, 2048, StZGate{act, DRY(rep)});
        }
        }
        if (ph + 1 < ph_hi) xcd_barrier(wid0, xb);
    }
}

extern "C" void kernel_launch(void* const* d_in, const int* in_sizes, int n_in, void* d_out, int out_size, void* d_ws, size_t ws_size, hipStream_t stream) {
    static int grid = 0;
    if (grid == 0) {
        if (ws_size < WS_END) { fprintf(stderr, "kernel_launch: workspace too small: %zu < %zu\n", ws_size, (size_t)WS_END); grid = -1; return; }
        int dev = 0, cus = 0, per_cu = 0;
        hipGetDevice(&dev); hipDeviceGetAttribute(&cus, hipDeviceAttributeMultiprocessorCount, dev);
        if (hipFuncSetAttribute((const void*)mega, hipFuncAttributeMaxDynamicSharedMemorySize, LDS_BYTES) != hipSuccess) { fprintf(stderr, "kernel_launch: hipFuncSetAttribute failed\n"); grid = -1; return; }
        if (hipOccupancyMaxActiveBlocksPerMultiprocessor(&per_cu, (const void*)mega, 512, LDS_BYTES) != hipSuccess || per_cu < 1) per_cu = 1;
        (void)hipGetLastError();
        grid = 256; (void)cus;
        if (grid <= 0) grid = 256;
    }
    if (grid < 0) return;
    Params p{};
    p.x = (const float*)d_in[0]; p.meta = (const float*)d_in[1]; p.g_norm = (const float*)d_in[2]; p.gla_w_in = (const float*)d_in[3]; p.gla_wgu = (const float*)d_in[4];
    p.gla_bg = (const float*)d_in[5]; p.gla_gn = (const float*)d_in[6]; p.gla_w_out = (const float*)d_in[7]; p.diff_w_in = (const float*)d_in[8]; p.diff_lam = (const float*)d_in[9];
    p.diff_gn = (const float*)d_in[10]; p.diff_w_out = (const float*)d_in[11]; p.rel_bias = (const float*)d_in[12]; p.g_final = (const float*)d_in[13];
    p.out = (float*)d_out; p.ws = (unsigned char*)d_ws;
    if (hipMemsetAsync((char*)d_ws + WS_BAR, 0, 16384, stream) != hipSuccess) { fprintf(stderr, "kernel_launch: memset failed\n"); return; }
#if MULTI_LAUNCH
#ifndef DBG_LAST
#define DBG_LAST 21
#endif
    for (int ph = 0; ph < NPHASES; ++ph) {
        if (ph > DBG_LAST && ph != NPHASES - 1) continue;
        if ((DBG_SKIP >> ph) & 1) continue;
        p.ph_lo = ph; p.ph_hi = ph + 1;
        hipLaunchKernelGGL(mega, dim3(grid), dim3(512), LDS_BYTES, stream, p);
    }
#else
    p.ph_lo = 0; p.ph_hi = NPHASES;
    void* args[] = {&p};
    hipError_t e = hipLaunchCooperativeKernel((void*)mega, dim3(grid), dim3(512), args, LDS_BYTES, stream);
    if (e != hipSuccess) fprintf(stderr, "cooperative launch failed: %s (grid %d)\n", hipGetErrorString(e), grid);
#endif
}
```

```cpp
#include <hip/hip_runtime.h>
#include <hip/hip_cooperative_groups.h>
#include <cstdio>
namespace cg = cooperative_groups;

#define DBG_LAST 21
#define DBG_SKIP 0x0
#ifndef DBG_DOUBLE
#define DBG_DOUBLE 0x0
#endif
#define DRY(rep) ((((DBG_DOUBLE >> kind) & 1) != 0) && (rep) == 0)
#ifndef MULTI_LAUNCH
#define MULTI_LAUNCH 0
#endif

#ifndef ONLY
#define ONLY -1
#endif
#define EN(k) (ONLY == -1 || ONLY == (k))
#define DI __device__ __forceinline__
#define LAS __attribute__((address_space(3)))
typedef unsigned short bf16_t;
typedef short bf16x8 __attribute__((ext_vector_type(8)));
typedef short s16x4 __attribute__((ext_vector_type(4)));
typedef float f32x4 __attribute__((ext_vector_type(4)));
typedef float f32x16 __attribute__((ext_vector_type(16)));
typedef unsigned u32x4 __attribute__((ext_vector_type(4)));
typedef unsigned u32x2 __attribute__((ext_vector_type(2)));

constexpr int MREG = 32768;
constexpr int RCONT = MREG + 64;
constexpr size_t RALLOC = MREG + 128;
constexpr size_t WS_HMETA = 0;
constexpr size_t WS_BIAS = 65536;
constexpr size_t WS_OMETA = 65536 + 8192;
constexpr size_t WS_BAR = 196608;
constexpr size_t WS_WIN = 262144;
constexpr size_t WS_WOUT = WS_WIN + 16777216;
constexpr size_t WS_WG = WS_WOUT + 4194304;
constexpr size_t WS_HN = WS_WG + 32768;
constexpr size_t WS_ACT = WS_HN + RALLOC * 2048;
constexpr size_t WS_ATTN = WS_ACT + RALLOC * 12288;
constexpr size_t WS_E = WS_ATTN + (size_t)513 * 4 * 4096 * 2;
constexpr size_t WS_GLR = WS_E + (size_t)513 * 4 * 256 * 4;
constexpr size_t WS_END = WS_GLR + RALLOC * 64;
constexpr int LDS_BYTES = 147456;
constexpr int NPHASES = 23;

struct Params {
    const float *x, *meta, *g_norm, *gla_w_in, *gla_wgu, *gla_bg, *gla_gn, *gla_w_out, *diff_w_in, *diff_lam, *diff_gn, *diff_w_out, *rel_bias, *g_final;
    float* out; unsigned char* ws; int ph_lo, ph_hi;
};

DI int opaque_bid() { int b = blockIdx.x; asm volatile("" : "+s"(b)); return b; }
DI int opaque_gdim() { int g = gridDim.x; asm volatile("" : "+s"(g)); return g; }
DI int hw_lane() { unsigned z = 0u; asm volatile("" : "+s"(z)); return (int)__builtin_amdgcn_mbcnt_hi(~0u, __builtin_amdgcn_mbcnt_lo(~0u, z)); }
DI int opaque_tid(int wid0) { int w = wid0; asm volatile("" : "+s"(w)); return w * 64 + hw_lane(); }
typedef __bf16 bf16v2_t __attribute__((ext_vector_type(2)));
typedef float f32x2_t __attribute__((ext_vector_type(2)));
DI unsigned cvt_pk_bf16(float lo, float hi) { const f32x2_t v = {lo, hi}; const bf16v2_t b = __builtin_convertvector(v, bf16v2_t); return __builtin_bit_cast(unsigned, b); }
DI float bf2f(short b) { return __uint_as_float(((unsigned)(unsigned short)b) << 16); }
#define SWZ_XOR(v, x) __int_as_float(__builtin_amdgcn_ds_swizzle(__float_as_int(v), 0x1F | ((x) << 10)))
DI float half_sum(float v) { v += SWZ_XOR(v, 1); v += SWZ_XOR(v, 2); v += SWZ_XOR(v, 4); v += SWZ_XOR(v, 8); v += SWZ_XOR(v, 16); return v; }
DI float wave_sum(float v) { v = half_sum(v); auto rr = __builtin_amdgcn_permlane32_swap(__float_as_uint(v), __float_as_uint(v), false, false); return __uint_as_float(rr[0]) + __uint_as_float(rr[1]); }
DI int crow(int r, int hi) { return (r & 3) + 8 * (r >> 2) + 4 * hi; }
#define MFMA16(a, b, c) __builtin_amdgcn_mfma_f32_16x16x32_bf16((a), (b), (c), 0, 0, 0)
#define MFMA32(a, b, c) __builtin_amdgcn_mfma_f32_32x32x16_bf16((a), (b), (c), 0, 0, 0)

namespace pg8 {
constexpr int BM = 256, BK = 64, HALF = 128, HTB = HALF * BK * 2, STAGE_BYTES = 8 * HTB, NXCD = 8, WGM = 8;
DI int lds_byte(int r, int c) { const int st = (r >> 4) * 2 + (c >> 5), rr = r & 15, cc = c & 31, ob = rr * 64 + cc * 2; return st * 1024 + (ob ^ (((ob >> 9) & 1) << 5)); }
DI void stage_rc(int b, int& R, int& C) { const int st = b / 1024, sb = b % 1024, swz = sb ^ (((sb >> 9) & 1) << 5); R = (st >> 1) * 16 + swz / 64; C = (st & 1) * 32 + (swz % 64) / 2; }
DI int perm32(int rho) { const int n = rho >> 4, i = rho & 15; return 8 * (i >> 2) + 4 * n + (i & 3); }
struct Unit { int pm, pn; };
struct Gemm { const bf16_t* A; const bf16_t* Bt; int M, N, K; };
struct StaticOrder {
    int nM, nN, nwg, G, c;
    DI void init(int M, int N, int G_, int c_) { nM = M / BM; nN = N / BM; nwg = nM * nN; G = G_; c = c_; }
    DI bool next(int i, Unit& u) const {
        const long L = (long)i * G + c; if (L >= nwg) return false;
        int wgid = (int)L; { const int q = nwg / NXCD, r = nwg % NXCD, xcd = wgid % NXCD, off = wgid / NXCD; wgid = (xcd < r ? xcd * (q + 1) : r * (q + 1) + (xcd - r) * q) + off; }
        const int nig = WGM * nN, gid = wgid / nig, fm = gid * WGM, gsz = (nM - fm) < WGM ? (nM - fm) : WGM;
        u.pm = fm + ((wgid % nig) % gsz); u.pn = (wgid % nig) / gsz; return true;
    }
};
template <class F> struct EpiGen {
    F f;
    DI void operator()(const f32x4 (&acc)[2][2][4][2], const Unit& u, int wr, int wc, int fr, int fq) const {
        const int row0 = u.pm * BM + wr * 64 + fr, col0 = u.pn * BM + wc * 32 + 8 * fq;
#pragma unroll
        for (int ai = 0; ai < 2; ++ai)
#pragma unroll
            for (int m = 0; m < 4; ++m)
#pragma unroll
                for (int bj = 0; bj < 2; ++bj) f.store8(row0 + ai * HALF + m * 16, col0 + bj * HALF, acc[ai][bj][m][0], acc[ai][bj][m][1]);
    }
};

template <class Epi>
DI void gemm_phase(int wid0, LAS unsigned char* lds, const Gemm g, const StaticOrder& S, const Epi& E) {
    const int tid = opaque_tid(wid0), wid = __builtin_amdgcn_readfirstlane(tid >> 6), lane = tid & 63, wr = wid >> 2, wc = wid & 3, fr = lane & 15, fq = lane >> 4;
    const int K = g.K, nt = K / BK;
    unsigned voffA[2], voffB[2];
#pragma unroll
    for (int i = 0; i < 2; ++i) { int R, C; stage_rc(tid * 16 + i * 8192, R, C); const int Rb = (R & ~31) + perm32(R & 31); voffA[i] = (unsigned)(R * K + C) * 2u; voffB[i] = (unsigned)(Rb * K + C) * 2u; }
    const size_t kstep = (size_t)(BK * 2);
    const size_t hstep = (size_t)HALF * K * 2;
    const size_t tstep = 2 * hstep;
    const unsigned ldsw = (unsigned)wid * 1024u;
    const int aoff = lds_byte(wr * 64 + fr, fq * 8), boff = lds_byte(wc * 32 + fr, fq * 8);
#define PG8_SA(b, h) (((b) * 2 + (h)) * HTB)
#define PG8_SB(b, h) ((4 + (b) * 2 + (h)) * HTB)
#define PG8_STAGE(bufoff, gbase, voff) do { _Pragma("unroll") for (int _i = 0; _i < 2; ++_i) \
        __builtin_amdgcn_global_load_lds((const unsigned*)((const char*)(gbase) + (voff)[_i]), (LAS unsigned*)(lds + (bufoff) + ldsw + _i * 8192), 16, 0, 0); } while (0)
#define PG8_LDA(dst, b, h) do { _Pragma("unroll") for (int m = 0; m < 4; ++m) _Pragma("unroll") for (int k = 0; k < 2; ++k) dst[m][k] = *(const LAS bf16x8*)(lds + PG8_SA(b, h) + aoff + m * 2048 + k * 1024); } while (0)
#define PG8_LDB(dst, b, h) do { _Pragma("unroll") for (int n = 0; n < 2; ++n) _Pragma("unroll") for (int k = 0; k < 2; ++k) dst[n][k] = *(const LAS bf16x8*)(lds + PG8_SB(b, h) + boff + n * 2048 + k * 1024); } while (0)
#define PG8_MMA(ai, bj, At, Bt) do { __builtin_amdgcn_s_setprio(1); _Pragma("unroll") for (int m = 0; m < 4; ++m) _Pragma("unroll") for (int n = 0; n < 2; ++n) _Pragma("unroll") for (int k = 0; k < 2; ++k) \
        acc[ai][bj][m][n] = __builtin_amdgcn_mfma_f32_16x16x32_bf16(Bt[n][k], At[m][k], acc[ai][bj][m][n], 0, 0, 0); __builtin_amdgcn_s_setprio(0); } while (0)
#define PG8_WAIT_V(n) asm volatile("s_waitcnt vmcnt(" #n ")" ::: "memory")
#define PG8_WAIT_L(n) asm volatile("s_waitcnt lgkmcnt(" #n ")" ::: "memory")
#define PG8_BAR __builtin_amdgcn_s_barrier()
#define PG8_SCHED __builtin_amdgcn_sched_barrier(0)
    Unit cur, nxt; int ui = 0;
    if (!S.next(0, cur)) return;
    f32x4 acc[2][2][4][2];
#pragma unroll
    for (int a = 0; a < 2; ++a)
#pragma unroll
        for (int b = 0; b < 2; ++b)
#pragma unroll
            for (int m = 0; m < 4; ++m)
#pragma unroll
                for (int n = 0; n < 2; ++n) acc[a][b][m][n] = (f32x4){0.f, 0.f, 0.f, 0.f};
    bf16x8 At[4][2], B0[2][2], B1[2][2];
    const char* cA = (const char*)g.A + (size_t)cur.pm * tstep; const char* cB = (const char*)g.Bt + (size_t)cur.pn * tstep;
    PG8_STAGE(PG8_SB(0, 0), cB, voffB); PG8_STAGE(PG8_SB(0, 1), cB + hstep, voffB); PG8_STAGE(PG8_SA(0, 0), cA, voffA); PG8_STAGE(PG8_SA(0, 1), cA + hstep, voffA);
    if (wr == 1) PG8_BAR;
    PG8_WAIT_V(2); PG8_BAR;
    PG8_STAGE(PG8_SB(1, 0), cB + kstep, voffB); PG8_STAGE(PG8_SA(1, 0), cA + kstep, voffA); PG8_STAGE(PG8_SB(1, 1), cB + hstep + kstep, voffB);
    PG8_WAIT_V(6); PG8_BAR;
    for (;;) {
        const bool has_next = S.next(ui + 1, nxt);
        const char* nA = has_next ? (const char*)g.A + (size_t)nxt.pm * tstep : cA; const char* nB = has_next ? (const char*)g.Bt + (size_t)nxt.pn * tstep : cB;
        for (int t = 0; t < nt; t += 2) {
            const bool last = (t == nt - 2);
            const char* a1 = cA + (size_t)(t + 1) * kstep;
            const char* a2 = last ? nA : cA + (size_t)(t + 2) * kstep; const char* b2 = last ? nB : cB + (size_t)(t + 2) * kstep;
            const char* a3 = a2 + kstep; const char* b3 = b2 + kstep;
            PG8_LDB(B0, 0, 0); PG8_LDB(B1, 0, 1); PG8_SCHED; PG8_LDA(At, 0, 0); PG8_STAGE(PG8_SA(1, 1), a1 + hstep, voffA);
            PG8_WAIT_V(8); PG8_WAIT_L(0); PG8_BAR; PG8_MMA(0, 0, At, B0); PG8_MMA(0, 1, At, B1); PG8_BAR; PG8_SCHED;
            PG8_LDA(At, 0, 1); PG8_STAGE(PG8_SB(0, 0), b2, voffB); PG8_STAGE(PG8_SB(0, 1), b2 + hstep, voffB); PG8_STAGE(PG8_SA(0, 0), a2, voffA);
            PG8_WAIT_V(8); PG8_WAIT_L(0); PG8_BAR; PG8_MMA(1, 0, At, B0); PG8_MMA(1, 1, At, B1); PG8_BAR; PG8_SCHED;
            PG8_LDB(B0, 1, 0); PG8_LDB(B1, 1, 1); PG8_SCHED; PG8_LDA(At, 1, 0); PG8_STAGE(PG8_SA(0, 1), a2 + hstep, voffA);
            PG8_WAIT_V(8); PG8_WAIT_L(0); PG8_BAR; PG8_MMA(0, 0, At, B0); PG8_MMA(0, 1, At, B1); PG8_BAR; PG8_SCHED;
            PG8_LDA(At, 1, 1); PG8_STAGE(PG8_SB(1, 0), b3, voffB); PG8_STAGE(PG8_SB(1, 1), b3 + hstep, voffB); PG8_STAGE(PG8_SA(1, 0), a3, voffA);
            PG8_WAIT_V(8); PG8_WAIT_L(0); PG8_BAR; PG8_MMA(1, 0, At, B0); PG8_MMA(1, 1, At, B1); PG8_BAR; PG8_SCHED;
        }
        if (wr == 0) PG8_BAR;
        E(acc, cur, wr, wc, fr, fq);
        if (!has_next) break;
#pragma unroll
        for (int a = 0; a < 2; ++a)
#pragma unroll
            for (int b = 0; b < 2; ++b)
#pragma unroll
                for (int m = 0; m < 4; ++m)
#pragma unroll
                    for (int n = 0; n < 2; ++n) acc[a][b][m][n] = (f32x4){0.f, 0.f, 0.f, 0.f};
        cur = nxt; cA = nA; cB = nB; ++ui;
        if (wr == 1) PG8_BAR;
    }
    PG8_WAIT_V(0);
    PG8_BAR;
#undef PG8_SA
#undef PG8_SB
#undef PG8_STAGE
#undef PG8_LDA
#undef PG8_LDB
#undef PG8_MMA
#undef PG8_WAIT_V
#undef PG8_WAIT_L
#undef PG8_BAR
#undef PG8_SCHED
}
}

struct StGlaIn {
    bf16_t* act;
    DI void operator()(int row, int col, f32x4 a) const {
        bf16_t* d;
        if (col < 1024) d = act + (size_t)row * 1024 + col;
        else if (col < 2048) d = act + RALLOC * 1024 + (size_t)row * 1024 + (col - 1024);
        else if (col < 4096) d = act + RALLOC * 2048 + (size_t)row * 2048 + (col - 2048);
        else d = act + RALLOC * 4096 + (size_t)row * 2048 + (col - 4096);
        u32x2 w; w.x = cvt_pk_bf16(a[0], a[1]); w.y = cvt_pk_bf16(a[2], a[3]); *(u32x2*)d = w;
    }
    DI void store8(int row, int col, f32x4 a, f32x4 b) const {
        bf16_t* d;
        if (col < 1024) d = act + (size_t)row * 1024 + col;
        else if (col < 2048) d = act + RALLOC * 1024 + (size_t)row * 1024 + (col - 1024);
        else if (col < 4096) d = act + RALLOC * 2048 + (size_t)row * 2048 + (col - 2048);
        else d = act + RALLOC * 4096 + (size_t)row * 2048 + (col - 4096);
        u32x4 w; w.x = cvt_pk_bf16(a[0], a[1]); w.y = cvt_pk_bf16(a[2], a[3]); w.z = cvt_pk_bf16(b[0], b[1]); w.w = cvt_pk_bf16(b[2], b[3]); *(u32x4*)d = w;
    }
};
struct StDiffIn {
    bf16_t* act;
    DI void operator()(int row, int col, f32x4 a) const {
        bf16_t* d = act + (size_t)(col >> 11) * (RALLOC * 2048) + (size_t)row * 2048 + (col & 2047);
        u32x2 w; w.x = cvt_pk_bf16(a[0], a[1]); w.y = cvt_pk_bf16(a[2], a[3]); *(u32x2*)d = w;
    }
    DI void store8(int row, int col, f32x4 a, f32x4 b) const {
        bf16_t* d = act + (size_t)(col >> 11) * (RALLOC * 2048) + (size_t)row * 2048 + (col & 2047);
        u32x4 w; w.x = cvt_pk_bf16(a[0], a[1]); w.y = cvt_pk_bf16(a[2], a[3]); w.z = cvt_pk_bf16(b[0], b[1]); w.w = cvt_pk_bf16(b[2], b[3]); *(u32x4*)d = w;
    }
};
struct StZGate {
    bf16_t* o; bool dry;
    DI void operator()(int row, int col, f32x4 a) const {
        bf16_t* d = o + (size_t)row * 2048 + col;
        const u32x2 ov = *(const u32x2*)d;
        float of[4] = {__uint_as_float(ov.x << 16), __uint_as_float(ov.x & 0xffff0000u), __uint_as_float(ov.y << 16), __uint_as_float(ov.y & 0xffff0000u)};
        float y[4];
#pragma unroll
        for (int i = 0; i < 4; ++i) { const float z = a[i]; y[i] = z / (1.f + __expf(-z)) * of[i]; }
        u32x2 w; w.x = cvt_pk_bf16(y[0], y[1]); w.y = cvt_pk_bf16(y[2], y[3]); if (!dry) *(u32x2*)d = w;
    }
    DI void store8(int row, int col, f32x4 a, f32x4 b) const {
        bf16_t* d = o + (size_t)row * 2048 + col;
        const u32x4 ov = *(const u32x4*)d;
        const unsigned ow[4] = {ov.x, ov.y, ov.z, ov.w}; float y[8];
#pragma unroll
        for (int i = 0; i < 8; ++i) { const float z = i < 4 ? a[i] : b[i - 4]; const float of = (i & 1) ? __uint_as_float(ow[i >> 1] & 0xffff0000u) : __uint_as_float(ow[i >> 1] << 16); y[i] = z / (1.f + __expf(-z)) * of; }
        u32x4 w; w.x = cvt_pk_bf16(y[0], y[1]); w.y = cvt_pk_bf16(y[2], y[3]); w.z = cvt_pk_bf16(y[4], y[5]); w.w = cvt_pk_bf16(y[6], y[7]); if (!dry) *(u32x4*)d = w;
    }
};
struct StResid {
    const float* src; float* dst; int rowoff; bool dry;
    DI void operator()(int row, int col, f32x4 a) const {
        const size_t o = (size_t)(row - rowoff) * 1024 + col;
        const f32x4 s = *(const f32x4*)(src + o); if (!dry) *(f32x4*)(dst + o) = s + a;
    }
    DI void store8(int row, int col, f32x4 a, f32x4 b) const {
        const size_t o = (size_t)(row - rowoff) * 1024 + col;
        const f32x4 s0 = *(const f32x4*)(src + o), s1 = *(const f32x4*)(src + o + 4);
        if (!dry) { *(f32x4*)(dst + o) = s0 + a; *(f32x4*)(dst + o + 4) = s1 + b; }
    }
};
struct StGlr {
    float* glr;
    DI void operator()(int row, int col, f32x4 a) const { *(f32x4*)(glr + (size_t)row * 16 + col) = a; }
};

template <class St>
DI void mini_gemm(int wid0, const bf16_t* A, int lda, int arow0, int nrt, const bf16_t* Bt, int K, int N, const St& st) {
    const int tid_ = opaque_tid(wid0), lane = tid_ & 63, wave = tid_ >> 6, nw = opaque_gdim() * 8, nct = N / 16;
    const int gw = (wave * opaque_gdim() + opaque_bid());
    for (int t = gw; t < nrt * nct; t += nw) {
        const int rt = t % nrt, ct = t / nrt;
        const bf16_t* ap = A + (size_t)(arow0 + rt * 16 + (lane & 15)) * lda + 8 * (lane >> 4);
        const bf16_t* bp = Bt + (size_t)(ct * 16 + (lane & 15)) * K + 8 * (lane >> 4);
        f32x4 acc0 = (f32x4){0.f, 0.f, 0.f, 0.f}, acc1 = (f32x4){0.f, 0.f, 0.f, 0.f};
        for (int k0 = 0; k0 < K; k0 += 256) {
            bf16x8 a[8], b[8];
#pragma unroll
            for (int j = 0; j < 8; ++j) { a[j] = *(const bf16x8*)(ap + k0 + 32 * j); b[j] = *(const bf16x8*)(bp + k0 + 32 * j); }
#pragma unroll
            for (int j = 0; j < 8; j += 2) { acc0 = MFMA16(b[j], a[j], acc0); acc1 = MFMA16(b[j + 1], a[j + 1], acc1); }
        }
        st(arow0 + rt * 16 + (lane & 15), ct * 16 + 4 * (lane >> 4), acc0 + acc1);
    }
}
DI void glr_gemm(int wid0, const bf16_t* hn, const bf16_t* WgT, float* glr) {
    const int tid_ = opaque_tid(wid0), lane = tid_ & 63, wave = tid_ >> 6, nw = opaque_gdim() * 8;
    const int gw = ((7 - wave) * opaque_gdim() + opaque_bid());
    for (int t = gw; t < RCONT / 64; t += nw) {
        const bf16_t* ap = hn + (size_t)(t * 64 + (lane & 15)) * 1024 + 8 * (lane >> 4);
        const bf16_t* bp = WgT + (size_t)(lane & 15) * 1024 + 8 * (lane >> 4);
        f32x4 acc[4];
#pragma unroll
        for (int c = 0; c < 4; ++c) acc[c] = (f32x4){0.f, 0.f, 0.f, 0.f};
#pragma unroll 4
        for (int k0 = 0; k0 < 1024; k0 += 32) {
            const bf16x8 b = *(const bf16x8*)(bp + k0);
#pragma unroll
            for (int c = 0; c < 4; ++c) { const bf16x8 a = *(const bf16x8*)(ap + (size_t)c * 16 * 1024 + k0); acc[c] = MFMA16(b, a, acc[c]); }
        }
#pragma unroll
        for (int c = 0; c < 4; ++c) *(f32x4*)(glr + (size_t)(t * 64 + c * 16 + (lane & 15)) * 16 + 4 * (lane >> 4)) = acc[c];
    }
}

DI void phase_bias(int wid0, const Params& p) {
    float* T = (float*)(p.ws + WS_BIAS);
    const int i = opaque_bid() * 512 + opaque_tid(wid0);
    if (i < 8 * 129) {
        const int h = i / 129, n = i % 129; int bucket;
        if (n < 16) bucket = n;
        else { const float nf = (float)n; int lg = 16 + (int)(logf(nf / 16.f) / logf(8.f) * 16.f); bucket = lg < 31 ? lg : 31; }
        T[i] = p.rel_bias[bucket * 8 + h] * 1.4426950408889634f;
    }
}
DI void phase_norm(int wid0, const Params& p, int L) {
    const float* hreg = (L == 0) ? p.x : p.out; const float* hmeta = (L == 0) ? p.meta : (const float*)(p.ws + WS_HMETA);
    const float* g = p.g_norm + L * 1024; bf16_t* hn = (bf16_t*)(p.ws + WS_HN);
    const int tid_ = opaque_tid(wid0), wave = tid_ >> 6, lane = tid_ & 63, stride = opaque_gdim() * 8;
    f32x4 gv[4];
#pragma unroll
    for (int i = 0; i < 4; ++i) gv[i] = *(const f32x4*)(g + i * 256 + lane * 4);
    for (int row0 = opaque_bid() * 8 + wave; row0 < RCONT; row0 += 2 * stride) {
        f32x4 v[2][4]; float ss[2] = {0.f, 0.f};
#pragma unroll
        for (int q = 0; q < 2; ++q) {
            const int row = row0 + q * stride;
            if (row < MREG + 16) {
                const float* src = row < MREG ? hreg + (size_t)row * 1024 : hmeta + (size_t)(row - MREG) * 1024;
#pragma unroll
                for (int i = 0; i < 4; ++i) v[q][i] = *(const f32x4*)(src + i * 256 + lane * 4);
            } else {
#pragma unroll
                for (int i = 0; i < 4; ++i) v[q][i] = (f32x4){0.f, 0.f, 0.f, 0.f};
            }
        }
#pragma unroll
        for (int q = 0; q < 2; ++q) {
#pragma unroll
            for (int i = 0; i < 4; ++i) ss[q] += v[q][i][0] * v[q][i][0] + v[q][i][1] * v[q][i][1] + v[q][i][2] * v[q][i][2] + v[q][i][3] * v[q][i][3];
            ss[q] = wave_sum(ss[q]);
        }
#pragma unroll
        for (int q = 0; q < 2; ++q) {
            const int row = row0 + q * stride;
            if (row < RCONT) {
                const float rstd = rsqrtf(ss[q] * (1.f / 1024.f) + 1e-6f);
                bf16_t* dst = hn + (size_t)row * 1024;
#pragma unroll
                for (int i = 0; i < 4; ++i) {
                    u32x2 w; w.x = cvt_pk_bf16(v[q][i][0] * rstd * gv[i][0], v[q][i][1] * rstd * gv[i][1]); w.y = cvt_pk_bf16(v[q][i][2] * rstd * gv[i][2], v[q][i][3] * rstd * gv[i][3]);
                    *(u32x2*)(dst + i * 256 + lane * 4) = w;
                }
            }
        }
    }
}
DI void phase_final(int wid0, const Params& p) {
    const int tid_ = opaque_tid(wid0), wave = tid_ >> 6, lane = tid_ & 63;
    for (int row = opaque_bid() * 8 + wave; row < MREG; row += opaque_gdim() * 8) {
        float* src = p.out + (size_t)row * 1024;
        f32x4 v[4]; float ss = 0.f;
#pragma unroll
        for (int i = 0; i < 4; ++i) { v[i] = *(const f32x4*)(src + i * 256 + lane * 4); ss += v[i][0] * v[i][0] + v[i][1] * v[i][1] + v[i][2] * v[i][2] + v[i][3] * v[i][3]; }
        ss = wave_sum(ss);
        const float rstd = rsqrtf(ss * (1.f / 1024.f) + 1e-6f);
#pragma unroll
        for (int i = 0; i < 4; ++i) { const f32x4 gv = *(const f32x4*)(p.g_final + i * 256 + lane * 4); *(f32x4*)(src + i * 256 + lane * 4) = v[i] * rstd * gv; }
    }
}
DI void wconv_tile(const float* W, int ldw, int K, bf16_t* Bt, int k0, int n0, float* tile, int lane) {
#pragma unroll
    for (int i = 0; i < 16; ++i) {
        const int k = (lane >> 4) + 4 * i, n4 = (lane & 15) * 4;
        const f32x4 v = *(const f32x4*)(W + (size_t)(k0 + k) * ldw + n0 + n4);
        tile[k * 65 + n4] = v[0]; tile[k * 65 + n4 + 1] = v[1]; tile[k * 65 + n4 + 2] = v[2]; tile[k * 65 + n4 + 3] = v[3];
    }
    asm volatile("s_waitcnt lgkmcnt(0)" ::: "memory");
#pragma unroll
    for (int i = 0; i < 8; ++i) {
        const int n = (lane >> 3) + 8 * i, k8 = (lane & 7) * 8;
        float e[8];
#pragma unroll
        for (int j = 0; j < 8; ++j) e[j] = tile[(k8 + j) * 65 + n];
        u32x4 w; w.x = cvt_pk_bf16(e[0], e[1]); w.y = cvt_pk_bf16(e[2], e[3]); w.z = cvt_pk_bf16(e[4], e[5]); w.w = cvt_pk_bf16(e[6], e[7]);
        *(u32x4*)(Bt + (size_t)(n0 + n) * K + k0 + k8) = w;
    }
    asm volatile("s_waitcnt lgkmcnt(0)" ::: "memory");
}
DI void wconv_all(int wid0, const float* Win, int Nmain, int ldw, bf16_t* win, const float* Wout, bf16_t* wout, unsigned char* lds) {
    const int tid = opaque_tid(wid0), lane = tid & 63, wave = tid >> 6, nw = opaque_gdim() * 8;
    float* tile = (float*)(lds + wave * 16640);
    const int t1 = 16 * (Nmain / 64), ttot = t1 + 32 * 16;
    for (int t = wave * opaque_gdim() + opaque_bid(); t < ttot; t += nw) {
        if (t < t1) wconv_tile(Win, ldw, 1024, win, (t & 15) * 64, (t >> 4) * 64, tile, lane);
        else { const int u = t - t1; wconv_tile(Wout, 1024, 2048, wout, (u & 31) * 64, (u >> 5) * 64, tile, lane); }
    }
}
DI void phase_wconv(int wid0, const Params& p, int L, unsigned char* lds) {
    const int li = L >> 1;
    bf16_t* win = (bf16_t*)(p.ws + WS_WIN); bf16_t* wout = (bf16_t*)(p.ws + WS_WOUT); bf16_t* wg = (bf16_t*)(p.ws + WS_WG);
    if ((L & 1) == 0) {
        const float* W = p.gla_w_in + (size_t)li * 1024 * 6160;
        wconv_all(wid0, W, 6144, 6160, win, p.gla_w_out + (size_t)li * 2048 * 1024, wout, lds);
        for (int i = opaque_bid() * 512 + opaque_tid(wid0); i < 16 * 1024; i += opaque_gdim() * 512) { const int r = i >> 10, k = i & 1023; wg[i] = (bf16_t)(cvt_pk_bf16(W[(size_t)k * 6160 + 6144 + r], 0.f) & 0xffffu); }
    } else {
        wconv_all(wid0, p.diff_w_in + (size_t)li * 1024 * 8192, 8192, 8192, win, p.diff_w_out + (size_t)li * 2048 * 1024, wout, lds);
    }
}

DI void phase_prep(int wid0, const Params& p, int L, unsigned char* lds, bool dry) {
    const int gi = L >> 1, tid = opaque_tid(wid0), wave = tid >> 6, lane = tid & 63, r32 = lane & 31, hi = lane >> 5;
    const float* wgu = p.gla_wgu + (size_t)gi * 16 * 1024; const float* bg = p.gla_bg + (size_t)gi * 1024;
    bf16_t* act = (bf16_t*)(p.ws + WS_ACT); bf16_t* qb = act; bf16_t* kb = act + RALLOC * 1024;
    bf16_t* khT = (bf16_t*)(p.ws + WS_HN); bf16_t* attn = (bf16_t*)(p.ws + WS_ATTN); float* Eo = (float*)(p.ws + WS_E); const float* glr = (const float*)(p.ws + WS_GLR);
    float* bs = (float*)lds; float* tot = (float*)(lds + 65536); float* gl = (float*)(lds + 67584); bf16_t* qs = (bf16_t*)(lds + 71680); bf16_t* xs = (bf16_t*)(lds + 105472);
    for (int u = opaque_bid(); u < 513 * 4; u += opaque_gdim()) {
        const int g = u >> 2, hd = u & 3; const bool ismeta = (g == 512); const int row0 = ismeta ? MREG : g * 64;
        for (int i = tid; i < 1024; i += 512) gl[i] = glr[(size_t)row0 * 16 + i];
        bf16x8 qreg[4], kreg[4];
#pragma unroll
        for (int it = 0; it < 4; ++it) {
            const int gid = tid + 512 * it, i = gid >> 5, d8 = (gid & 31) * 8;
            const size_t goff = (size_t)(row0 + i) * 1024 + hd * 256 + d8;
            qreg[it] = *(const bf16x8*)(qb + goff); kreg[it] = *(const bf16x8*)(kb + goff);
        }
        __syncthreads();
        {
            const int d = tid & 255, ih = tid >> 8; float w[16];
#pragma unroll
            for (int r = 0; r < 16; ++r) w[r] = wgu[r * 1024 + hd * 256 + d];
            const float bgd = bg[hd * 256 + d]; float run = 0.f;
            for (int ii = 0; ii < 32; ++ii) {
                const int i = ih * 32 + ii; float x = bgd;
                const f32x4 g0 = *(const f32x4*)(gl + i * 16), g1 = *(const f32x4*)(gl + i * 16 + 4), g2 = *(const f32x4*)(gl + i * 16 + 8), g3 = *(const f32x4*)(gl + i * 16 + 12);
#pragma unroll
                for (int r = 0; r < 4; ++r) { x = fmaf(g0[r], w[r], x); x = fmaf(g1[r], w[4 + r], x); x = fmaf(g2[r], w[8 + r], x); x = fmaf(g3[r], w[12 + r], x); }
                float lgv = (fminf(x, 0.f) - __logf(1.f + __expf(-fabsf(x)))) * 0.0625f;
                if (ismeta && i >= 16) lgv = 0.f;
                run += lgv; bs[i * 256 + d] = run;
            }
            tot[ih * 256 + d] = run;
        }
        asm volatile("s_waitcnt vmcnt(0)" ::: "memory");
        __syncthreads();
#pragma unroll
        for (int it = 0; it < 4; ++it) {
            const int gid = tid + 512 * it, i = gid >> 5, d8 = (gid & 31) * 8;
            const bf16x8 qv = qreg[it]; const bf16x8 kv = kreg[it];
            float qt[8];
            const f32x4 bsv[2] = {*(const f32x4*)(bs + i * 256 + d8), *(const f32x4*)(bs + i * 256 + d8 + 4)};
            const f32x4 t0v[2] = {*(const f32x4*)(tot + d8), *(const f32x4*)(tot + d8 + 4)};
            const f32x4 t1v[2] = {*(const f32x4*)(tot + 256 + d8), *(const f32x4*)(tot + 256 + d8 + 4)};
#pragma unroll
            for (int e = 0; e < 8; ++e) {
                const float b = bsv[e >> 2][e & 3] + (i >= 32 ? t0v[e >> 2][e & 3] : 0.f); const float bl = t0v[e >> 2][e & 3] + t1v[e >> 2][e & 3];
                qt[e] = bf2f(qv[e]) * 0.0625f * __expf(b);
                const float kh = bf2f(kv[e]) * __expf(bl - b);
                xs[(d8 + e) * 64 + (i ^ (2 * ((d8 >> 3) & 31)))] = (bf16_t)(cvt_pk_bf16(kh, 0.f) & 0xffffu);
            }
            u32x4 w; w.x = cvt_pk_bf16(qt[0], qt[1]); w.y = cvt_pk_bf16(qt[2], qt[3]); w.z = cvt_pk_bf16(qt[4], qt[5]); w.w = cvt_pk_bf16(qt[6], qt[7]);
            {
                const int ob = (((i >> 4) * 8 + (d8 >> 5)) * 64 + ((d8 & 31) >> 3) * 16 + (i & 15)) * 16;
                *(u32x4*)(qb + (size_t)(row0 + (ob >> 9)) * 1024 + hd * 256 + ((ob & 511) >> 1)) = w;
            }
            *(u32x4*)(qs + i * 264 + d8) = w;
        }
        __syncthreads();
#pragma unroll
        for (int it = 0; it < 4; ++it) {
            const int gid = tid + 512 * it, d = gid >> 3, j8 = gid & 7, sw = (d >> 3) & 31;
            u32x4 w = *(const u32x4*)(xs + d * 64 + ((j8 ^ (sw >> 2)) * 8));
            if (sw & 1) w = (u32x4){w.y, w.x, w.w, w.z};
            if (sw & 2) w = (u32x4){w.z, w.w, w.x, w.y};
            *(u32x4*)(khT + (size_t)u * 16384 + ((((d >> 5) * 4 + (j8 >> 1)) * 64 + (j8 & 1) * 32 + (d & 31)) * 8)) = w;
        }
        if (tid < 256) Eo[(size_t)u * 256 + tid] = __expf(tot[tid] + tot[256 + tid]);
        __syncthreads();
#pragma unroll
        for (int it = 0; it < 4; ++it) {
            const int gid = tid + 512 * it, i = gid >> 5, d8 = (gid & 31) * 8; float kt[8];
            const f32x4 bsv[2] = {*(const f32x4*)(bs + i * 256 + d8), *(const f32x4*)(bs + i * 256 + d8 + 4)};
            const f32x4 t0v[2] = {*(const f32x4*)(tot + d8), *(const f32x4*)(tot + d8 + 4)};
#pragma unroll
            for (int e = 0; e < 8; ++e) { const float b = bsv[e >> 2][e & 3] + (i >= 32 ? t0v[e >> 2][e & 3] : 0.f); kt[e] = bf2f(kreg[it][e]) * __expf(-b); }
            u32x4 w; w.x = cvt_pk_bf16(kt[0], kt[1]); w.y = cvt_pk_bf16(kt[2], kt[3]); w.z = cvt_pk_bf16(kt[4], kt[5]); w.w = cvt_pk_bf16(kt[6], kt[7]);
            *(u32x4*)(xs + i * 264 + d8) = w;
        }
        __syncthreads();
        if (wave < 4) {
            const int ib = wave >> 1, jb = wave & 1; f32x16 acc;
#pragma unroll
            for (int i = 0; i < 16; ++i) acc[i] = 0.f;
            if (!(ib == 0 && jb == 1)) {
#pragma unroll
                for (int s = 0; s < 16; ++s) {
                    const bf16x8 a = *(const bf16x8*)(qs + (32 * ib + r32) * 264 + 16 * s + 8 * hi);
                    const bf16x8 b = *(const bf16x8*)(xs + (32 * jb + r32) * 264 + 16 * s + 8 * hi);
                    acc = MFMA32(a, b, acc);
                }
            }
#pragma unroll
            for (int i = 0; i < 16; ++i) {
                const int row = 32 * ib + crow(i, hi), col = 32 * jb + r32; const float v = (col <= row) ? acc[i] : 0.f;
                attn[(size_t)u * 4096 + ((((row >> 4) * 2 + (col >> 5)) * 64 + ((col & 31) >> 3) * 16 + (row & 15)) * 8) + (col & 7)] = (bf16_t)(cvt_pk_bf16(v, 0.f) & 0xffffu);
            }
        }
        __syncthreads();
    }
}

DI s16x4 tr_read0(unsigned addr) { return __builtin_amdgcn_ds_read_tr16_b64_v4i16((LAS s16x4*)(size_t)addr); }
#define PK8(L, H) (bf16x8){L[0], L[1], L[2], L[3], H[0], H[1], H[2], H[3]}
DI void phase_scan(int wid0, const Params& p, unsigned char* lds, bool dry) {
    const int tid = opaque_tid(wid0), wave = __builtin_amdgcn_readfirstlane(tid >> 6), lane = tid & 63, r32 = lane & 31, hi = lane >> 5, l15 = lane & 15, l4 = lane >> 4;
    bf16_t* act = (bf16_t*)(p.ws + WS_ACT); const bf16_t* qb = act; bf16_t* vb = act + RALLOC * 2048;
    const bf16_t* khT = (const bf16_t*)(p.ws + WS_HN); const bf16_t* attn = (const bf16_t*)(p.ws + WS_ATTN); const float* Eo = (const float*)(p.ws + WS_E);
    bf16_t* ometa = (bf16_t*)(p.ws + WS_OMETA);
    bf16_t* sbt = (bf16_t*)lds; bf16_t* vs = (bf16_t*)(lds + 67584);
    const unsigned vs_base = (unsigned)(size_t)(LAS unsigned char*)(lds + 67584);
    for (int u = opaque_bid(); u < 256; u += opaque_gdim()) {
        const int xcd = u & 7, ix = u >> 3, bh = xcd * 4 + (ix >> 3), vsi = ix & 7, b = bh >> 2, hd = bh & 3, colv = hd * 512 + vsi * 64;
        f32x16 S0, S1;
#pragma unroll
        for (int i = 0; i < 16; ++i) { S0[i] = 0.f; S1[i] = 0.f; }
        for (int i = tid; i < 33792 / 16; i += 512) *(u32x4*)((unsigned char*)sbt + i * 16) = (u32x4){0u, 0u, 0u, 0u};
        const int vj = tid >> 3, vc8 = (tid & 7) * 8;
        u32x4 vnext = *(const u32x4*)(vb + (size_t)(MREG + vj) * 2048 + colv + vc8);
        for (int c = 0; c < 65; ++c) {
            const int g = (c == 0) ? 512 : b * 64 + (c - 1), row0 = (c == 0) ? MREG : g * 64, ug = g * 4 + hd, cur = c & 1;
            *(u32x4*)(vs + cur * 4608 + vj * 72 + vc8) = vnext;
            __syncthreads();
            if (c + 1 < 65) vnext = *(const u32x4*)(vb + (size_t)((b * 64 + c) * 64 + vj) * 2048 + colv + vc8);
            const int ib = wave >> 1, cb0 = 2 * (wave & 1), i = 16 * ib + l15;
            const unsigned vao = vs_base + (unsigned)(cur * 9216 + (8 * l4 + (l15 >> 2)) * 144 + 2 * (16 * cb0 + 4 * (l15 & 3)));
            const unsigned vau = vs_base + (unsigned)(cur * 9216 + (8 * hi + (l15 >> 2)) * 144 + 2 * (16 * ((lane >> 4) & 1) + 4 * (l15 & 3)));
            s16x4 ol[2][2], oh[2][2], ul0[4], uh0[4], ul1[4], uh1[4];
#pragma unroll
            for (int cc = 0; cc < 2; ++cc)
#pragma unroll
                for (int s = 0; s < 2; ++s) { ol[cc][s] = tr_read0(vao + cc * 32 + s * 32 * 144); oh[cc][s] = tr_read0(vao + cc * 32 + s * 32 * 144 + 4 * 144); }
#pragma unroll
            for (int s = 0; s < 2; ++s) {
                ul0[s] = tr_read0(vau + s * 16 * 144); uh0[s] = tr_read0(vau + s * 16 * 144 + 4 * 144);
                ul1[s] = tr_read0(vau + s * 16 * 144 + 64); uh1[s] = tr_read0(vau + s * 16 * 144 + 4 * 144 + 64);
            }
            {
                const bf16_t* ap = attn + (size_t)ug * 4096 + (ib * 2 * 64 + lane) * 8;
                bf16x8 at[2], aq[8];
#pragma unroll
                for (int s = 0; s < 2; ++s) at[s] = *(const bf16x8*)(ap + s * 512);
#pragma unroll
                for (int s = 0; s < 8; ++s) { const int ob = ((ib * 8 + s) * 64 + lane) * 16; aq[s] = *(const bf16x8*)(qb + (size_t)(row0 + (ob >> 9)) * 1024 + hd * 256 + ((ob & 511) >> 1)); }
                __builtin_amdgcn_sched_barrier(0);
                f32x4 oacc[2];
#pragma unroll
                for (int cc = 0; cc < 2; ++cc) {
                    const int cb = cb0 + cc; oacc[cc] = (f32x4){0.f, 0.f, 0.f, 0.f};
#pragma unroll
                    for (int s = 0; s < 2; ++s) oacc[cc] = MFMA16(PK8(ol[cc][s], oh[cc][s]), at[s], oacc[cc]);
                    const bf16_t* sp = sbt + cur * 16896 + (16 * cb + l15) * 264 + 8 * l4;
#pragma unroll
                    for (int s = 0; s < 8; ++s) { const bf16x8 bfr = *(const bf16x8*)(sp + 32 * s); oacc[cc] = MFMA16(bfr, aq[s], oacc[cc]); }
                }
#pragma unroll
                for (int s = 2; s < 4; ++s) {
                    ul0[s] = tr_read0(vau + s * 16 * 144); uh0[s] = tr_read0(vau + s * 16 * 144 + 4 * 144);
                    ul1[s] = tr_read0(vau + s * 16 * 144 + 64); uh1[s] = tr_read0(vau + s * 16 * 144 + 4 * 144 + 64);
                }
#pragma unroll
                for (int cc = 0; cc < 2; ++cc) {
                    const int col = colv + 16 * (cb0 + cc) + 4 * l4;
                    u32x2 w; w.x = cvt_pk_bf16(oacc[cc][0], oacc[cc][1]); w.y = cvt_pk_bf16(oacc[cc][2], oacc[cc][3]);
                    if (dry) {} else if (c > 0) *(u32x2*)(vb + (size_t)(row0 + i) * 2048 + col) = w;
                    else if (b == 0 && i < 16) *(u32x2*)(ometa + (size_t)i * 2048 + col) = w;
                }
            }
            {
                const bf16_t* kp = khT + (size_t)ug * 16384 + (wave * 4 * 64 + lane) * 8;
                bf16x8 kt[4];
#pragma unroll
                for (int s = 0; s < 4; ++s) kt[s] = *(const bf16x8*)(kp + s * 512);
                const float* ep = Eo + (size_t)ug * 256 + 32 * wave + 4 * hi;
#pragma unroll
                for (int g4 = 0; g4 < 4; ++g4) { const f32x4 ev = *(const f32x4*)(ep + 8 * g4);
#pragma unroll
                    for (int j = 0; j < 4; ++j) { S0[4 * g4 + j] *= ev[j]; S1[4 * g4 + j] *= ev[j]; } }
                __builtin_amdgcn_sched_barrier(0);
#pragma unroll
                for (int s = 0; s < 4; ++s) {
                    S0 = MFMA32(kt[s], PK8(ul0[s], uh0[s]), S0);
                    S1 = MFMA32(kt[s], PK8(ul1[s], uh1[s]), S1);
                }
                bf16_t* wp = sbt + (cur ^ 1) * 16896 + r32 * 264 + 32 * wave + 4 * hi;
#pragma unroll
                for (int g4 = 0; g4 < 4; ++g4) {
                    u32x2 w0; w0.x = cvt_pk_bf16(S0[4 * g4], S0[4 * g4 + 1]); w0.y = cvt_pk_bf16(S0[4 * g4 + 2], S0[4 * g4 + 3]);
                    u32x2 w1; w1.x = cvt_pk_bf16(S1[4 * g4], S1[4 * g4 + 1]); w1.y = cvt_pk_bf16(S1[4 * g4 + 2], S1[4 * g4 + 3]);
                    *(u32x2*)(wp + 8 * g4) = w0; *(u32x2*)(wp + 32 * 264 + 8 * g4) = w1;
                }
            }
        }
        __syncthreads();
    }
}

DI void phase_gate(int wid0, const Params& p, int L, bool dry) {
    const int tid_ = opaque_tid(wid0), lane = tid_ & 63, gw = opaque_bid() * 8 + (tid_ >> 6), nw = opaque_gdim() * 8;
    bf16_t* act = (bf16_t*)(p.ws + WS_ACT); const bf16_t* vb = act + RALLOC * 2048; bf16_t* zb = act + RALLOC * 4096; const bf16_t* ometa = (const bf16_t*)(p.ws + WS_OMETA);
    const float* gn = p.gla_gn + (size_t)(L >> 1) * 2048;
    for (int t = gw; t < (MREG + 16) * 4; t += nw) {
        const int row = t >> 2, hd = t & 3;
        const bf16_t* op = row < MREG ? vb + (size_t)row * 2048 + hd * 512 + lane * 8 : ometa + (size_t)(row - MREG) * 2048 + hd * 512 + lane * 8;
        bf16_t* zp = zb + (size_t)row * 2048 + hd * 512 + lane * 8;
        const bf16x8 ov = *(const bf16x8*)op; const bf16x8 zv = *(const bf16x8*)zp;
        float of[8], ss = 0.f;
#pragma unroll
        for (int e = 0; e < 8; ++e) { of[e] = bf2f(ov[e]); ss += of[e] * of[e]; }
        ss = wave_sum(ss);
        const float rstd = rsqrtf(ss * (1.f / 512.f) + 1e-6f);
        const f32x4 g0 = *(const f32x4*)(gn + hd * 512 + lane * 8), g1 = *(const f32x4*)(gn + hd * 512 + lane * 8 + 4);
        float y[8];
#pragma unroll
        for (int e = 0; e < 8; ++e) { const float z = bf2f(zv[e]); y[e] = z / (1.f + __expf(-z)) * of[e] * rstd * (e < 4 ? g0[e] : g1[e - 4]); }
        u32x4 w; w.x = cvt_pk_bf16(y[0], y[1]); w.y = cvt_pk_bf16(y[2], y[3]); w.z = cvt_pk_bf16(y[4], y[5]); w.w = cvt_pk_bf16(y[6], y[7]);
        if (!dry) *(u32x4*)zp = w;
    }
}

constexpr float ATT_C = 0.088388347648318440f * 1.4426950408889634f;
constexpr float ATT_THR2 = 8.f * 1.4426950408889634f;
#define KSWZ(row, colB) ((row) * 256 + ((colB) ^ (((row) & 7) << 4)))
DI int v_rd_base(int lane) { return ((lane & 3) << 3) | (((lane >> 2) & 3) << 6) | (((lane >> 4) & 1) << 5) | (((lane >> 5) & 1) << 8); }
constexpr int v_rd_off(int d0, int ks, int half) { return d0 * 512 + ks * 8192 + half * 4096; }
template <int OFF> DI s16x4 tr_read(int vb) { s16x4 r; asm volatile("ds_read_b64_tr_b16 %0, %1 offset:%2" : "=&v"(r) : "v"(vb), "i"(OFF) : "memory"); return r; }
template <int D0> DI void pv_two(f32x16& oa, f32x16& ob, int vb, bf16x8 pa0, bf16x8 pa1) {
    const s16x4 l0 = tr_read<v_rd_off(D0, 0, 0)>(vb), h0 = tr_read<v_rd_off(D0, 0, 1)>(vb), l1 = tr_read<v_rd_off(D0, 1, 0)>(vb), h1 = tr_read<v_rd_off(D0, 1, 1)>(vb);
    const s16x4 l2 = tr_read<v_rd_off(D0 + 1, 0, 0)>(vb), h2 = tr_read<v_rd_off(D0 + 1, 0, 1)>(vb), l3 = tr_read<v_rd_off(D0 + 1, 1, 0)>(vb), h3 = tr_read<v_rd_off(D0 + 1, 1, 1)>(vb);
    asm volatile("s_waitcnt lgkmcnt(0)" ::: "memory"); __builtin_amdgcn_sched_barrier(0);
    oa = MFMA32(pa0, PK8(l0, h0), oa);
    ob = MFMA32(pa0, PK8(l2, h2), ob);
    oa = MFMA32(pa1, PK8(l1, h1), oa);
    ob = MFMA32(pa1, PK8(l3, h3), ob);
    __builtin_amdgcn_sched_barrier(0);
}
DI void attn_stage(const bf16_t* kbase, const bf16_t* vbase, unsigned koff, unsigned voff, LAS unsigned char* ldsbuf, int wid) {
#pragma unroll
    for (int i = 0; i < 2; ++i) {
        const char* src = (const char*)kbase + (size_t)(i * 128) * 2;
        __builtin_amdgcn_global_load_lds((const unsigned*)(src + koff), (LAS unsigned*)(ldsbuf + (wid + 8 * i) * 1024), 16, 0, 0);
    }
#pragma unroll
    for (int i = 0; i < 2; ++i) {
        const char* src = (const char*)vbase + (size_t)(16 * i * 2048) * 2;
        __builtin_amdgcn_global_load_lds((const unsigned*)(src + voff), (LAS unsigned*)(ldsbuf + 16384 + (wid + 8 * i) * 1024), 16, 0, 0);
    }
}
DI void finalize_attn(const Params& p, unsigned char* lds, f32x16 (&o)[8], float l_reg, int lane_k, int wid, bool meta, int qrow0, int hh, int di, float lambda_init, bool dry) {
    int lane = (lane_k < 0) ? hw_lane() : lane_k; asm volatile("" : "+v"(lane));
    const int r32 = lane & 31, hi = lane >> 5, rg = wid & 3, psub = wid >> 2;
    float* wsx = (float*)(lds + 132096) + wid * 64; float* li_l = wsx; const float* misc = (const float*)(lds + 134144);
    float* X = (float*)lds; bf16_t* qbuf = (bf16_t*)(p.ws + WS_ACT);
    if (hi == 0) li_l[r32] = l_reg;
    asm volatile("s_waitcnt lgkmcnt(0)" ::: "memory");
    {
        const float sc = psub ? -misc[0] : 1.f;
#pragma unroll
        for (int r = 0; r < 16; ++r) {
            const float c = sc / li_l[crow(r, hi)];
#pragma unroll
            for (int d = 0; d < 8; ++d) o[d][r] *= c;
        }
    }
    __syncthreads();
    if (psub == 1) {
#pragma unroll
        for (int d = 0; d < 8; ++d)
#pragma unroll
            for (int r = 0; r < 16; ++r) X[(rg * 128 + d * 16 + r) * 64 + lane] = o[d][r];
    }
    __syncthreads();
    if (psub == 0) {
#pragma unroll
        for (int d = 0; d < 8; ++d)
#pragma unroll
            for (int r = 0; r < 16; ++r) o[d][r] += X[(rg * 128 + d * 16 + r) * 64 + lane];
        asm volatile("s_waitcnt lgkmcnt(0)" ::: "memory");
        float* R = (float*)(lds + rg * 32768);
#pragma unroll
        for (int d = 0; d < 8; ++d)
#pragma unroll
            for (int r = 0; r < 16; ++r) R[crow(r, hi) * 256 + 32 * d + r32] = o[d][r];
        asm volatile("s_waitcnt lgkmcnt(0)" ::: "memory");
        const float og = 1.f - misc[1]; const int c8 = (lane & 31) * 8;
        const f32x4 g0 = *(const f32x4*)(p.diff_gn + (size_t)di * 256 + c8) * og, g1 = *(const f32x4*)(p.diff_gn + (size_t)di * 256 + c8 + 4) * og;
        bf16_t* dstb = qbuf + (size_t)(qrow0 + 32 * rg + (lane >> 5)) * 2048 + hh * 256 + c8;
        const int nrow = dry ? 0 : (meta ? (rg == 0 ? 16 : 0) : 32);
#pragma unroll 2
        for (int it = 0; it < 16; ++it) {
            const int row = 2 * it + (lane >> 5);
            f32x4 a = *(const f32x4*)(R + row * 256 + c8), b = *(const f32x4*)(R + row * 256 + c8 + 4);
            float ss = a[0] * a[0] + a[1] * a[1] + a[2] * a[2] + a[3] * a[3] + b[0] * b[0] + b[1] * b[1] + b[2] * b[2] + b[3] * b[3];
            ss = half_sum(ss);
            const float rstd = rsqrtf(ss * (1.f / 256.f) + 1e-6f);
            a = a * rstd * g0; b = b * rstd * g1;
            u32x4 w; w.x = cvt_pk_bf16(a[0], a[1]); w.y = cvt_pk_bf16(a[2], a[3]); w.z = cvt_pk_bf16(b[0], b[1]); w.w = cvt_pk_bf16(b[2], b[3]);
            if (row < nrow) *(u32x4*)(dstb + (size_t)it * 4096) = w;
        }
    }
}
DI void phase_attn(int wid0, const Params& p, int L, unsigned char* lds, bool dry) {
    const int di = L >> 1; const float lambda_init = 0.8f - 0.6f * __expf(-0.3f * (float)L);
    const int tid = opaque_tid(wid0), wid = __builtin_amdgcn_readfirstlane(tid >> 6), lane_k = tid & 63, rg = wid & 3, psub = wid >> 2;
    LAS unsigned char* ldsl = (LAS unsigned char*)lds;
    float* tab = (float*)(lds + 131072); float* wsx = (float*)(lds + 132096) + wid * 64; float* li_l = wsx; float* al_l = wsx + 32; float* misc = (float*)(lds + 134144);
    float* X = (float*)lds;
    bf16_t* act = (bf16_t*)(p.ws + WS_ACT); bf16_t* qbuf = act; const bf16_t* kbuf = act + RALLOC * 2048; const bf16_t* vbuf = act + RALLOC * 4096;
    const float* biasT = (const float*)(p.ws + WS_BIAS);
    if (wid == 0) {
        const float* lv = p.diff_lam + (size_t)di * 512;
        const int lane = lane_k; float s1 = lv[lane] * lv[128 + lane] + lv[64 + lane] * lv[192 + lane], s2 = lv[256 + lane] * lv[384 + lane] + lv[320 + lane] * lv[448 + lane];
        s1 = wave_sum(s1); s2 = wave_sum(s2);
        if (lane == 0) { misc[0] = __expf(s1) - __expf(s2) + lambda_init; misc[1] = lambda_init; }
    }
    __syncthreads();
    const int G = opaque_gdim(), blk = opaque_bid();
    for (int ui = 0;; ++ui) {
        int b, hh, qb; bool meta = false;
        int lane = lane_k; asm volatile("" : "+v"(lane));
        const int r32 = lane & 31, hi = lane >> 5;
        unsigned koff, voff;
        { const int row = 4 * wid + (lane >> 4), gsrc = (lane & 15) ^ (row & 7); koff = (unsigned)(row * 2048 + 8 * gsrc) * 2u;
          const int w5 = (lane & 31) >> 2, kl = (w5 & 3) + 8 * (w5 >> 2) + 4 * (wid >> 2), col = ((2 * wid + (lane >> 5)) & 7) * 32 + (lane & 3) * 8; voff = (unsigned)(kl * 2048 + col) * 2u; }

        if (G == 256) {
            if (ui < 8) { const int bh = 8 * ui + (blk & 7), j = blk >> 3; qb = (ui & 1) ? 31 - j : j; b = bh >> 3; hh = bh & 7; }
            else if (ui == 8 && blk < 8) { meta = true; hh = blk; b = 0; qb = 0; }
            else break;
        } else {
            const int u = blk + ui * G;
            if (u < 2048) { const int bh = u & 63; qb = 31 - (u >> 6); b = bh >> 3; hh = bh & 7; }
            else if (u < 2056) { meta = true; hh = u - 2048; b = 0; qb = 0; }
            else break;
        }
        const int qrow0 = meta ? MREG : b * 4096 + 128 * qb, qpos0 = meta ? 0 : 16 + 128 * qb, ntiles = meta ? 1 : 1 + 4 * (qb + 1);
        if (tid < 130) tab[tid] = (tid < 129) ? biasT[hh * 129 + tid] : -__builtin_inff();
        int myrow = qrow0 + 32 * rg + r32; if (meta && myrow > MREG + 63) myrow = MREG + 63;
        const bf16_t* qp = qbuf + (size_t)myrow * 2048 + hh * 256 + psub * 128 + hi * 8;
        unsigned char* qlds = lds + wid * 8192 + lane * 16;
#pragma unroll
        for (int d0 = 0; d0 < 8; ++d0) *(bf16x8*)(qlds + d0 * 1024) = *(const bf16x8*)(qp + d0 * 16);
        const int wq0 = qpos0 + 32 * rg, qpos = wq0 + r32;
        const bf16_t* kh_ = kbuf + hh * 256; const bf16_t* vh_ = vbuf + hh * 256;
        attn_stage(kh_ + (size_t)MREG * 2048, vh_ + (size_t)MREG * 2048, koff, voff, ldsl + 65536, wid);
        f32x16 o[8];
#pragma unroll
        for (int d = 0; d < 8; ++d)
#pragma unroll
            for (int r = 0; r < 16; ++r) o[d][r] = 0.f;
        float m_reg = -1e30f, l_reg = 0.f;
        for (int t = 0; t < ntiles; ++t) {
            asm volatile("s_waitcnt vmcnt(0) lgkmcnt(0)" ::: "memory"); __builtin_amdgcn_s_barrier(); asm volatile("" ::: "memory");
            if (t + 1 < ntiles) attn_stage(kh_ + (size_t)(b * 4096 + 32 * t) * 2048, vh_ + (size_t)(b * 4096 + 32 * t) * 2048, koff, voff, ldsl + 65536 + ((t + 1) & 1) * 32768, wid);
            const int kpos0 = (t == 0) ? 0 : 16 + 32 * (t - 1);
            if (kpos0 <= wq0 + 31) {
                const unsigned char* Ks = lds + 65536 + (t & 1) * 32768 + psub * 8192;
                f32x16 p0, p0b;
#pragma unroll
                for (int r = 0; r < 16; ++r) { p0[r] = 0.f; p0b[r] = 0.f; }
                int swz = (r32 & 6) << 4, kro = r32 * 256 + ((hi ^ (r32 & 1)) << 4); asm volatile("" : "+v"(swz), "+v"(kro));
#pragma unroll
                for (int d0 = 0; d0 < 8; d0 += 2) {
                    const bf16x8 b0 = *(const bf16x8*)(Ks + kro + ((d0 * 32) ^ swz));
                    const bf16x8 qf = *(const bf16x8*)(qlds + d0 * 1024);
                    const bf16x8 b1 = *(const bf16x8*)(Ks + kro + (((d0 + 1) * 32) ^ swz));
                    const bf16x8 qg = *(const bf16x8*)(qlds + (d0 + 1) * 1024);
                    p0 = MFMA32(b0, qf, p0);
                    p0b = MFMA32(b1, qg, p0b);
                    if (d0 == 2) __builtin_amdgcn_sched_barrier(0);
                }
#pragma unroll
                for (int r = 0; r < 16; ++r) p0[r] += p0b[r];
                __builtin_amdgcn_sched_barrier(0);
                if (t > 0 && wq0 - (kpos0 + 31) >= 128) {
                    const float bfar = tab[128];
#pragma unroll
                    for (int r = 0; r < 16; ++r) p0[r] = fmaf(p0[r], ATT_C, bfar);
                } else {
#pragma unroll
                    for (int r = 0; r < 16; ++r) {
                        const int k0i = crow(r, hi);
                        const int d0v = qpos - (kpos0 + k0i);
                        const bool v0 = (d0v >= 0) && (t > 0 || k0i < 16);
                        const int idx = v0 ? (d0v < 128 ? d0v : 128) : 129;
                        p0[r] = fmaf(p0[r], ATT_C, tab[idx]);
                        if ((r & 3) == 3) __builtin_amdgcn_sched_barrier(0);
                    }
                }
                __builtin_amdgcn_sched_barrier(0);
                float pmax = p0[0];
#pragma unroll
                for (int r = 1; r < 16; ++r) pmax = fmaxf(pmax, p0[r]);
                { auto rr = __builtin_amdgcn_permlane32_swap(__float_as_uint(pmax), __float_as_uint(pmax), false, false); pmax = fmaxf(__uint_as_float(rr[0]), __uint_as_float(rr[1])); }
                float mn, alpha;
                if (__all(pmax - m_reg <= ATT_THR2)) { mn = m_reg; alpha = 1.f; }
                else { mn = fmaxf(m_reg, pmax); alpha = __builtin_amdgcn_exp2f(m_reg - mn); m_reg = mn; }
                float ps = 0.f;
#pragma unroll
                for (int r = 0; r < 16; ++r) { p0[r] = __builtin_amdgcn_exp2f(p0[r] - mn); ps += p0[r]; }
                { auto rr = __builtin_amdgcn_permlane32_swap(__float_as_uint(ps), __float_as_uint(ps), false, false); ps = __uint_as_float(rr[0]) + __uint_as_float(rr[1]); }
                l_reg = l_reg * alpha + ps;
                __builtin_amdgcn_sched_barrier(0);
                bf16x8 pa0, pa1;
#define PK4(P, BASE, OUT) do { unsigned a0 = cvt_pk_bf16(P[BASE + 0], P[BASE + 1]), a1 = cvt_pk_bf16(P[BASE + 2], P[BASE + 3]);   \
    unsigned b0_ = cvt_pk_bf16(P[BASE + 4], P[BASE + 5]), b1_ = cvt_pk_bf16(P[BASE + 6], P[BASE + 7]);                              \
    auto r0 = __builtin_amdgcn_permlane32_swap(a0, b0_, false, false); auto r1 = __builtin_amdgcn_permlane32_swap(a1, b1_, false, false); \
    u32x4 w_ = {r0[0], r1[0], r0[1], r1[1]}; OUT = __builtin_bit_cast(bf16x8, w_); } while (0)
                PK4(p0, 0, pa0); PK4(p0, 8, pa1);
#undef PK4
                __builtin_amdgcn_sched_barrier(0);
                if (__any(alpha < 1.f)) {
                    if (hi == 0) al_l[r32] = alpha;
                    asm volatile("s_waitcnt lgkmcnt(0)" ::: "memory");
                    float ar[16];
#pragma unroll
                    for (int r = 0; r < 16; ++r) ar[r] = al_l[crow(r, hi)];
#pragma unroll
                    for (int d = 0; d < 8; ++d)
#pragma unroll
                        for (int r = 0; r < 16; ++r) o[d][r] *= ar[r];
                }
                __builtin_amdgcn_sched_barrier(0);
                LAS unsigned char* vbp = ldsl + 65536 + (t & 1) * 32768 + 16384 + v_rd_base(lane);
                __builtin_amdgcn_s_setprio(1);
#define TRB(OFF) __builtin_amdgcn_ds_read_tr16_b64_v4i16((LAS s16x4*)(vbp + (OFF)))
#define PV_RD(D0, L0, H0, L1, H1) L0 = TRB(v_rd_off(D0, 0, 0)); H0 = TRB(v_rd_off(D0, 0, 1)); L1 = TRB(v_rd_off(D0, 1, 0)); H1 = TRB(v_rd_off(D0, 1, 1))
#define PV_MM(D0, L0, H0, L1, H1) o[D0] = MFMA32(pa0, PK8(L0, H0), o[D0]); o[D0] = MFMA32(pa1, PK8(L1, H1), o[D0])
#define SB() __builtin_amdgcn_sched_barrier(0)
                {
                    s16x4 a0, a1, a2, a3, b0_, b1_, b2_, b3_;
                    PV_RD(0, a0, a1, a2, a3); SB();
                    PV_RD(1, b0_, b1_, b2_, b3_); SB(); PV_MM(0, a0, a1, a2, a3); SB();
                    PV_RD(2, a0, a1, a2, a3); SB(); PV_MM(1, b0_, b1_, b2_, b3_); SB();
                    PV_RD(3, b0_, b1_, b2_, b3_); SB(); PV_MM(2, a0, a1, a2, a3); SB();
                    PV_RD(4, a0, a1, a2, a3); SB(); PV_MM(3, b0_, b1_, b2_, b3_); SB();
                    PV_RD(5, b0_, b1_, b2_, b3_); SB(); PV_MM(4, a0, a1, a2, a3); SB();
                    PV_RD(6, a0, a1, a2, a3); SB(); PV_MM(5, b0_, b1_, b2_, b3_); SB();
                    PV_RD(7, b0_, b1_, b2_, b3_); SB(); PV_MM(6, a0, a1, a2, a3); SB();
                    PV_MM(7, b0_, b1_, b2_, b3_); SB();
                }
#undef TRB
#undef PV_RD
#undef PV_MM
#undef SB
                __builtin_amdgcn_s_setprio(0);
            }
        }
        finalize_attn(p, lds, o, l_reg, lane_k, wid, meta, qrow0, hh, di, lambda_init, dry);
        __syncthreads();
    }
}


DI void attn_stage64(const bf16_t* kbase, const bf16_t* vbase, unsigned koff, unsigned voff, LAS unsigned char* ldsbuf, int wid) {
#pragma unroll
    for (int i = 0; i < 4; ++i) {
        const unsigned off = koff + (unsigned)((32 * (i & 1)) * 2048 + (i >> 1) * 128) * 2u;
        __builtin_amdgcn_global_load_lds((const unsigned*)((const char*)kbase + off), (LAS unsigned*)(ldsbuf + (wid + 8 * i) * 1024), 16, 0, 0);
    }
#pragma unroll
    for (int i = 0; i < 4; ++i) {
        const unsigned off = voff + (unsigned)(16 * i * 2048) * 2u;
        __builtin_amdgcn_global_load_lds((const unsigned*)((const char*)vbase + off), (LAS unsigned*)(ldsbuf + 32768 + (wid + 8 * i) * 1024), 16, 0, 0);
    }
}
template <int D0, int KH> DI void pv_two64(f32x16& oa, f32x16& ob, int vb, bf16x8 pa0, bf16x8 pa1) {
    const s16x4 l0 = tr_read<v_rd_off(D0, 2 * KH, 0)>(vb), h0 = tr_read<v_rd_off(D0, 2 * KH, 1)>(vb), l1 = tr_read<v_rd_off(D0, 2 * KH + 1, 0)>(vb), h1 = tr_read<v_rd_off(D0, 2 * KH + 1, 1)>(vb);
    const s16x4 l2 = tr_read<v_rd_off(D0 + 1, 2 * KH, 0)>(vb), h2 = tr_read<v_rd_off(D0 + 1, 2 * KH, 1)>(vb), l3 = tr_read<v_rd_off(D0 + 1, 2 * KH + 1, 0)>(vb), h3 = tr_read<v_rd_off(D0 + 1, 2 * KH + 1, 1)>(vb);
    asm volatile("s_waitcnt lgkmcnt(0)" ::: "memory"); __builtin_amdgcn_sched_barrier(0);
    oa = MFMA32(pa0, PK8(l0, h0), oa);
    ob = MFMA32(pa0, PK8(l2, h2), ob);
    oa = MFMA32(pa1, PK8(l1, h1), oa);
    ob = MFMA32(pa1, PK8(l3, h3), ob);
    __builtin_amdgcn_sched_barrier(0);
}
template <int KH> DI void attn_half(f32x16 (&o)[8], const bf16x8 (&qr)[8], float& m_reg, float& l_reg, const unsigned char* Ks, int vb0, const float* tab, float* al_l,
                                    int r32, int hi, int qpos, int wq0, int kpos0, bool t0) {
    if (kpos0 > wq0 + 31) return;
    f32x16 p0;
#pragma unroll
    for (int r = 0; r < 16; ++r) p0[r] = 0.f;
    int swz = (r32 & 6) << 4, kro = (32 * KH + r32) * 256 + ((hi ^ (r32 & 1)) << 4); asm volatile("" : "+v"(swz), "+v"(kro));
#pragma unroll
    for (int d0 = 0; d0 < 8; ++d0) {
        const bf16x8 b0 = *(const bf16x8*)(Ks + kro + ((d0 * 32) ^ swz));
        p0 = MFMA32(b0, qr[d0], p0);
        if (d0 == 3) __builtin_amdgcn_sched_barrier(0);
    }
    __builtin_amdgcn_sched_barrier(0);
    if (!t0 && wq0 - (kpos0 + 31) >= 128) {
        const float bfar = tab[128];
#pragma unroll
        for (int r = 0; r < 16; ++r) p0[r] = fmaf(p0[r], ATT_C, bfar);
    } else {
#pragma unroll
        for (int r = 0; r < 16; ++r) {
            const int k0i = crow(r, hi);
            const int d0v = qpos - (kpos0 + k0i);
            const bool v0 = (d0v >= 0) && (!t0 || k0i < 16);
            const int idx = v0 ? (d0v < 128 ? d0v : 128) : 129;
            p0[r] = fmaf(p0[r], ATT_C, tab[idx]);
            if ((r & 3) == 3) __builtin_amdgcn_sched_barrier(0);
        }
    }
    __builtin_amdgcn_sched_barrier(0);
    float pmax = p0[0];
#pragma unroll
    for (int r = 1; r < 16; ++r) pmax = fmaxf(pmax, p0[r]);
    { auto rr = __builtin_amdgcn_permlane32_swap(__float_as_uint(pmax), __float_as_uint(pmax), false, false); pmax = fmaxf(__uint_as_float(rr[0]), __uint_as_float(rr[1])); }
    float mn, alpha;
    if (__all(pmax - m_reg <= ATT_THR2)) { mn = m_reg; alpha = 1.f; }
    else { mn = fmaxf(m_reg, pmax); alpha = __builtin_amdgcn_exp2f(m_reg - mn); m_reg = mn; }
    float ps = 0.f;
#pragma unroll
    for (int r = 0; r < 16; ++r) { p0[r] = __builtin_amdgcn_exp2f(p0[r] - mn); ps += p0[r]; }
    { auto rr = __builtin_amdgcn_permlane32_swap(__float_as_uint(ps), __float_as_uint(ps), false, false); ps = __uint_as_float(rr[0]) + __uint_as_float(rr[1]); }
    l_reg = l_reg * alpha + ps;
    __builtin_amdgcn_sched_barrier(0);
    bf16x8 pa0, pa1;
#define PK4(P, BASE, OUT) do { unsigned a0 = cvt_pk_bf16(P[BASE + 0], P[BASE + 1]), a1 = cvt_pk_bf16(P[BASE + 2], P[BASE + 3]);   \
    unsigned b0_ = cvt_pk_bf16(P[BASE + 4], P[BASE + 5]), b1_ = cvt_pk_bf16(P[BASE + 6], P[BASE + 7]);                              \
    auto r0 = __builtin_amdgcn_permlane32_swap(a0, b0_, false, false); auto r1 = __builtin_amdgcn_permlane32_swap(a1, b1_, false, false); \
    u32x4 w_ = {r0[0], r1[0], r0[1], r1[1]}; OUT = __builtin_bit_cast(bf16x8, w_); } while (0)
    PK4(p0, 0, pa0); PK4(p0, 8, pa1);
#undef PK4
    __builtin_amdgcn_sched_barrier(0);
    if (__any(alpha < 1.f)) {
        if (hi == 0) al_l[r32] = alpha;
        asm volatile("s_waitcnt lgkmcnt(0)" ::: "memory");
        float ar[16];
#pragma unroll
        for (int r = 0; r < 16; ++r) ar[r] = al_l[crow(r, hi)];
#pragma unroll
        for (int d = 0; d < 8; ++d)
#pragma unroll
            for (int r = 0; r < 16; ++r) o[d][r] *= ar[r];
    }
    __builtin_amdgcn_sched_barrier(0);
    pv_two64<0, KH>(o[0], o[1], vb0, pa0, pa1); pv_two64<2, KH>(o[2], o[3], vb0, pa0, pa1); pv_two64<4, KH>(o[4], o[5], vb0, pa0, pa1); pv_two64<6, KH>(o[6], o[7], vb0, pa0, pa1);
}
DI void phase_attn64(int wid0, const Params& p, int L, unsigned char* lds, bool dry) {
    const int di = L >> 1; const float lambda_init = 0.8f - 0.6f * __expf(-0.3f * (float)L);
    const int tid = opaque_tid(wid0), wid = __builtin_amdgcn_readfirstlane(tid >> 6), lane_k = tid & 63, rg = wid & 3, psub = wid >> 2;
    LAS unsigned char* ldsl = (LAS unsigned char*)lds;
    float* tab = (float*)(lds + 131072); float* wsx = (float*)(lds + 132096) + wid * 64; float* al_l = wsx + 32; float* misc = (float*)(lds + 134144);
    bf16_t* act = (bf16_t*)(p.ws + WS_ACT); bf16_t* qbuf = act; const bf16_t* kbuf = act + RALLOC * 2048; const bf16_t* vbuf = act + RALLOC * 4096;
    const float* biasT = (const float*)(p.ws + WS_BIAS);
    if (wid == 0) {
        const float* lv = p.diff_lam + (size_t)di * 512;
        const int lane = lane_k; float s1 = lv[lane] * lv[128 + lane] + lv[64 + lane] * lv[192 + lane], s2 = lv[256 + lane] * lv[384 + lane] + lv[320 + lane] * lv[448 + lane];
        s1 = wave_sum(s1); s2 = wave_sum(s2);
        if (lane == 0) { misc[0] = __expf(s1) - __expf(s2) + lambda_init; misc[1] = lambda_init; }
    }
    __syncthreads();
    const int blk = opaque_bid();
    for (int ui = 0;; ++ui) {
        int b, hh, qb; bool meta = false;
        int lane = hw_lane(); asm volatile("" : "+v"(lane));
        const int r32 = lane & 31, hi = lane >> 5;
#define ATT_OFFS(LN) unsigned koff, voff; { int ln_ = (LN); asm volatile("" : "+v"(ln_)); const int row = 4 * wid + (ln_ >> 4), gsrc = (ln_ & 15) ^ (row & 7); koff = (unsigned)(row * 2048 + 8 * gsrc) * 2u; \
          const int w5 = (ln_ & 31) >> 2, kl = (w5 & 3) + 8 * (w5 >> 2) + 4 * (wid >> 2), col = ((2 * wid + (ln_ >> 5)) & 7) * 32 + (ln_ & 3) * 8; voff = (unsigned)(kl * 2048 + col) * 2u; }
        if (ui < 8) { const int bh = 8 * ui + (blk & 7), j = (blk >> 3) & 31; qb = (ui & 1) ? 31 - j : j; b = bh >> 3; hh = bh & 7; }
        else if (ui == 8 && blk < 8) { meta = true; hh = blk; b = 0; qb = 0; }
        else break;
        const int qrow0 = meta ? MREG : b * 4096 + 128 * qb, qpos0 = meta ? 0 : 16 + 128 * qb, ntiles = meta ? 1 : 1 + 2 * (qb + 1);
        { const int t_ = wid * 64 + lane; if (t_ < 130) tab[t_] = (t_ < 129) ? biasT[hh * 129 + t_] : -__builtin_inff(); }
        __builtin_amdgcn_sched_barrier(0);
        int myrow = qrow0 + 32 * rg + r32; if (meta && myrow > MREG + 63) myrow = MREG + 63;
        const bf16_t* qp = qbuf + (size_t)myrow * 2048 + hh * 256 + psub * 128 + hi * 8;
        bf16x8 qr[8];
#pragma unroll
        for (int d0 = 0; d0 < 8; ++d0) qr[d0] = *(const bf16x8*)(qp + d0 * 16);
        __builtin_amdgcn_sched_barrier(0);
        const int wq0 = qpos0 + 32 * rg, qpos = wq0 + r32;
        const bf16_t* kh_ = kbuf + hh * 256; const bf16_t* vh_ = vbuf + hh * 256;
        { ATT_OFFS(lane); attn_stage64(kh_ + (size_t)MREG * 2048, vh_ + (size_t)MREG * 2048, koff, voff, ldsl, wid); }
        __builtin_amdgcn_sched_barrier(0);
        f32x16 o[8];
#pragma unroll
        for (int d = 0; d < 8; ++d)
#pragma unroll
            for (int r = 0; r < 16; ++r) o[d][r] = 0.f;
        float m_reg = -1e30f, l_reg = 0.f;
        for (int t = 0; t < ntiles; ++t) {
            asm volatile("s_waitcnt vmcnt(0) lgkmcnt(0)" ::: "memory"); __builtin_amdgcn_s_barrier(); asm volatile("" ::: "memory");
            if (t + 1 < ntiles) { ATT_OFFS(lane); attn_stage64(kh_ + (size_t)(b * 4096 + 64 * t) * 2048, vh_ + (size_t)(b * 4096 + 64 * t) * 2048, koff, voff, ldsl + ((t + 1) & 1) * 65536, wid); }
            const int kpos0 = (t == 0) ? 0 : 16 + 64 * (t - 1);
            const unsigned char* Ks = lds + (t & 1) * 65536 + psub * 16384;
            const int vb0 = (int)(unsigned)(size_t)(ldsl + (t & 1) * 65536 + 32768) + v_rd_base(lane);
            attn_half<0>(o, qr, m_reg, l_reg, Ks, vb0, tab, al_l, r32, hi, qpos, wq0, kpos0, t == 0);
            if (t > 0) attn_half<1>(o, qr, m_reg, l_reg, Ks, vb0, tab, al_l, r32, hi, qpos, wq0, kpos0 + 32, false);
        }
        finalize_attn(p, lds, o, l_reg, -1, wid, meta, qrow0, hh, di, lambda_init, dry);
        __syncthreads();
    }
}

#define XB_TMO      128
#define XB_XCNT(j)  (256  + 64 * (j))
#define XB_XSUB(j)  (1280 + 64 * (j))
#define XB_XGEN(j)  (2304 + 64 * (j))
#define XB_TOP      3328
#define XB_TOPGEN   3392
#define XCD_BAR_WORDS 3456
#define XB_SPIN_CAP (1u << 22)
DI unsigned xb_ld(unsigned* p)              { return __hip_atomic_load(p, __ATOMIC_RELAXED, __HIP_MEMORY_SCOPE_AGENT); }
DI unsigned xb_add(unsigned* p, unsigned v) { return __hip_atomic_fetch_add(p, v, __ATOMIC_RELAXED, __HIP_MEMORY_SCOPE_AGENT); }
DI unsigned xb_xcc_id() { return (unsigned)__builtin_amdgcn_s_getreg((3 << 11) | 20) & 0xFu; }
#define XB_SPIN(cond, bar) do { unsigned _sp = 0; while (cond) { __builtin_amdgcn_s_sleep(1); \
    if ((++_sp & 255u) == 0u) { if (xb_ld(&(bar)[XB_TMO])) break; if (_sp > XB_SPIN_CAP) { atomicAdd(&(bar)[XB_TMO], 1u); break; } } } } while (0)
struct XcdBarrier { unsigned* bar; unsigned x; volatile LAS unsigned* st; };
DI XcdBarrier xcd_barrier_post(int wid0, unsigned* bar, volatile LAS unsigned* st) {
    XcdBarrier b; b.bar = bar; b.x = xb_xcc_id(); b.st = st;
    if (wid0 == 0 && hw_lane() == 0) (void)xb_add(&bar[XB_XCNT(b.x)], 1u);
    return b;
}
DI void xcd_barrier_complete(unsigned* bar, unsigned x, unsigned& nloc, unsigned& nx) {
    const unsigned G = (unsigned)opaque_gdim();
    unsigned sum, cnt, mine, sp = 0u;
    for (;;) {
        sum = 0u; cnt = 0u; mine = 0u;
#pragma unroll
        for (unsigned j = 0; j < 16; ++j) { const unsigned c = xb_ld(&bar[XB_XCNT(j)]); sum += c; cnt += (c > 0u) ? 1u : 0u; mine = (j == x) ? c : mine; }
        if (sum == G) break;
        __builtin_amdgcn_s_sleep(1);
        if ((++sp & 255u) == 0u) { if (xb_ld(&bar[XB_TMO])) break; if (sp > XB_SPIN_CAP) { atomicAdd(&bar[XB_TMO], 1u); break; } }
    }
    nloc = mine > 0u ? mine : 1u; nx = cnt > 0u ? cnt : 1u;
}
DI void xcd_barrier(int wid0, const XcdBarrier& b) {
    asm volatile("s_waitcnt vmcnt(0)" ::: "memory");
    __syncthreads();
    if (wid0 == 0 && hw_lane() == 0) {
        unsigned* bar = b.bar;
        __builtin_amdgcn_s_waitcnt(0);
        unsigned nloc = b.st[0], nx = b.st[1];
        if (nloc == 0u) { xcd_barrier_complete(bar, b.x, nloc, nx); b.st[0] = nloc; b.st[1] = nx; }
        const unsigned old = xb_add(&bar[XB_XSUB(b.x)], 1u);
        const unsigned gen = old / nloc;
        if (old + 1u == (gen + 1u) * nloc) {
            __builtin_amdgcn_fence(__ATOMIC_RELEASE, "agent");
            asm volatile("s_waitcnt vmcnt(0)" ::: "memory");
            const unsigned og = xb_add(&bar[XB_TOP], 1u);
            const unsigned tg = og / nx;
            if (og + 1u == (tg + 1u) * nx) xb_add(&bar[XB_TOPGEN], 1u);
            else XB_SPIN(xb_ld(&bar[XB_TOPGEN]) == tg, bar);
            __builtin_amdgcn_fence(__ATOMIC_ACQUIRE, "agent");
            xb_add(&bar[XB_XGEN(b.x)], 1u);
            asm volatile("s_waitcnt vmcnt(0)" ::: "memory");
        } else {
            XB_SPIN(xb_ld(&bar[XB_XGEN(b.x)]) == gen, bar);
            __builtin_amdgcn_fence(__ATOMIC_ACQUIRE, "agent");
            asm volatile("s_waitcnt vmcnt(0)" ::: "memory");
        }
    }
    __syncthreads();
}

__global__ void __launch_bounds__(512) mega(Params p_arg) {
    extern __shared__ __attribute__((aligned(16))) unsigned char lds[];
    cg::grid_group grid = cg::this_grid();
    const int ph_lo = p_arg.ph_lo, ph_hi = p_arg.ph_hi;
    if (ph_lo < 0) grid.sync();
    volatile LAS unsigned* xbst = (volatile LAS unsigned*)(LAS unsigned char*)(lds + LDS_BYTES - 16);
    const int wid0 = __builtin_amdgcn_readfirstlane((int)(threadIdx.x >> 6));
    if (wid0 == 0 && hw_lane() == 0) { xbst[0] = 0u; xbst[1] = 0u; }
    __syncthreads();
    XcdBarrier xb; xb.bar = (unsigned*)(p_arg.ws + WS_BAR); xb.x = 0; xb.st = xbst;
    if (ph_hi - ph_lo > 1) xb = xcd_barrier_post(wid0, (unsigned*)(p_arg.ws + WS_BAR), xbst);
    for (int ph = ph_lo; ph < ph_hi; ++ph) {
        const __attribute__((address_space(4))) Params* pp = (const __attribute__((address_space(4))) Params*)__builtin_amdgcn_kernarg_segment_ptr();
        asm volatile("" : "+s"(pp));
        Params p;
        p.x = pp->x; p.meta = pp->meta; p.g_norm = pp->g_norm; p.gla_w_in = pp->gla_w_in; p.gla_wgu = pp->gla_wgu; p.gla_bg = pp->gla_bg; p.gla_gn = pp->gla_gn; p.gla_w_out = pp->gla_w_out;
        p.diff_w_in = pp->diff_w_in; p.diff_lam = pp->diff_lam; p.diff_gn = pp->diff_gn; p.diff_w_out = pp->diff_w_out; p.rel_bias = pp->rel_bias; p.g_final = pp->g_final; p.out = pp->out; p.ws = pp->ws;
        p.ph_lo = ph_lo; p.ph_hi = ph_hi;
        bf16_t* act = (bf16_t*)(p.ws + WS_ACT); const bf16_t* hn = (const bf16_t*)(p.ws + WS_HN);
        const bf16_t* win = (const bf16_t*)(p.ws + WS_WIN); const bf16_t* wout = (const bf16_t*)(p.ws + WS_WOUT); const bf16_t* wg = (const bf16_t*)(p.ws + WS_WG);
        float* hmeta = (float*)(p.ws + WS_HMETA);
        const int G = opaque_gdim(), bid = opaque_bid();
        int L, kind;
        if (ph == 0) { L = 0; kind = 0; }
        else if (ph <= 6) { L = 0; kind = ph; }
        else if (ph <= 11) { L = 1; kind = ph; }
        else if (ph <= 17) { L = 2; kind = ph - 11; }
        else { L = 3; kind = ph - 11; }
        for (int rep = 0; rep < (((DBG_DOUBLE >> kind) & 1) && !(kind == 11 && L == 3) ? 2 : 1); ++rep) {
        if (EN(0) && kind == 0) { phase_bias(wid0, p); phase_norm(wid0, p, 0); phase_wconv(wid0, p, 0, lds); }
        else if (EN(1) && kind == 1) {
            pg8::Gemm g{hn, win, MREG, 6144, 1024}; pg8::StaticOrder S; S.init(MREG, 6144, G, bid);
            pg8::EpiGen<StGlaIn> E{StGlaIn{act}};
            pg8::gemm_phase(wid0, (LAS unsigned char*)lds, g, S, E);
            mini_gemm(wid0, hn, 1024, MREG, 4, win, 1024, 6144, StGlaIn{act});
            glr_gemm(wid0, hn, wg, (float*)(p.ws + WS_GLR));
        }
        else if (EN(2) && kind == 2) phase_prep(wid0, p, L, lds, DRY(rep));
        else if (EN(3) && kind == 3) phase_scan(wid0, p, lds, DRY(rep));
        else if (EN(4) && kind == 4) phase_gate(wid0, p, L, DRY(rep));
        else if (EN(5) && (kind == 5 || kind == 10)) {
            const bf16_t* A = (kind == 5) ? act + RALLOC * 4096 : act;
            const float* hsrc = (L == 0) ? p.x : p.out; const float* msrc = (L == 0) ? p.meta : hmeta;
            pg8::Gemm g{A, wout, MREG, 1024, 2048}; pg8::StaticOrder S; S.init(MREG, 1024, G, bid);
            pg8::EpiGen<StResid> E{StResid{hsrc, p.out, 0, DRY(rep)}};
            pg8::gemm_phase(wid0, (LAS unsigned char*)lds, g, S, E);
            mini_gemm(wid0, A, 2048, MREG, 1, wout, 2048, 1024, StResid{msrc, hmeta, MREG, DRY(rep)});
        }
        else if (EN(6) && (kind == 6 || kind == 11)) {
            if (L == 3) phase_final(wid0, p);
            else { phase_norm(wid0, p, L + 1); phase_wconv(wid0, p, L + 1, lds); }
        }
        else if (EN(7) && kind == 7) {
            pg8::Gemm g{hn, win, MREG, 6144, 1024}; pg8::StaticOrder S; S.init(MREG, 6144, G, bid);
            pg8::EpiGen<StDiffIn> E{StDiffIn{act}};
            pg8::gemm_phase(wid0, (LAS unsigned char*)lds, g, S, E);
            mini_gemm(wid0, hn, 1024, MREG, 4, win, 1024, 6144, StDiffIn{act});
        }
        else if (EN(8) && kind == 8) phase_attn(wid0, p, L, lds, DRY(rep));
        else if (EN(9) && kind == 9) {
            pg8::Gemm g{hn, win + (size_t)6144 * 1024, MREG, 2048, 1024}; pg8::StaticOrder S; S.init(MREG, 2048, G, bid);
            pg8::EpiGen<StZGate> E{StZGate{act, DRY(rep)}};
            pg8::gemm_phase(wid0, (LAS unsigned char*)lds, g, S, E);
            mini_gemm(wid0, hn, 1024, MREG, 1, win + (size_t)6144 * 1024, 1024, 2048, StZGate{act, DRY(rep)});
        }
        }
        if (ph + 1 < ph_hi) xcd_barrier(wid0, xb);
    }
}

extern "C" void kernel_launch(void* const* d_in, const int* in_sizes, int n_in, void* d_out, int out_size, void* d_ws, size_t ws_size, hipStream_t stream) {
    static int grid = 0;
    if (grid == 0) {
        if (ws_size < WS_END) { fprintf(stderr, "kernel_launch: workspace too small: %zu < %zu\n", ws_size, (size_t)WS_END); grid = -1; return; }
        int dev = 0, cus = 0, per_cu = 0;
        hipGetDevice(&dev); hipDeviceGetAttribute(&cus, hipDeviceAttributeMultiprocessorCount, dev);
        if (hipFuncSetAttribute((const void*)mega, hipFuncAttributeMaxDynamicSharedMemorySize, LDS_BYTES) != hipSuccess) { fprintf(stderr, "kernel_launch: hipFuncSetAttribute failed\n"); grid = -1; return; }
        if (hipOccupancyMaxActiveBlocksPerMultiprocessor(&per_cu, (const void*)mega, 512, LDS_BYTES) != hipSuccess || per_cu < 1) per_cu = 1;
        (void)hipGetLastError();
        grid = 256; (void)cus;
        if (grid <= 0) grid = 256;
    }
    if (grid < 0) return;
    Params p{};
    p.x = (const float*)d_in[0]; p.meta = (const float*)d_in[1]; p.g_norm = (const float*)d_in[2]; p.gla_w_in = (const float*)d_in[3]; p.gla_wgu = (const float*)d_in[4];
    p.gla_bg = (const float*)d_in[5]; p.gla_gn = (const float*)d_in[6]; p.gla_w_out = (const float*)d_in[7]; p.diff_w_in = (const float*)d_in[8]; p.diff_lam = (const float*)d_in[9];
    p.diff_gn = (const float*)d_in[10]; p.diff_w_out = (const float*)d_in[11]; p.rel_bias = (const float*)d_in[12]; p.g_final = (const float*)d_in[13];
    p.out = (float*)d_out; p.ws = (unsigned char*)d_ws;
    if (hipMemsetAsync((char*)d_ws + WS_BAR, 0, 16384, stream) != hipSuccess) { fprintf(stderr, "kernel_launch: memset failed\n"); return; }
#if MULTI_LAUNCH
#ifndef DBG_LAST
#define DBG_LAST 21
#endif
    for (int ph = 0; ph < NPHASES; ++ph) {
        if (ph > DBG_LAST && ph != NPHASES - 1) continue;
        if ((DBG_SKIP >> ph) & 1) continue;
        p.ph_lo = ph; p.ph_hi = ph + 1;
        hipLaunchKernelGGL(mega, dim3(grid), dim3(512), LDS_BYTES, stream, p);
    }
#else
    p.ph_lo = 0; p.ph_hi = NPHASES;
    void* args[] = {&p};
    hipError_t e = hipLaunchCooperativeKernel((void*)mega, dim3(grid), dim3(512), args, LDS_BYTES, stream);
    if (e != hipSuccess) fprintf(stderr, "cooperative launch failed: %s (grid %d)\n", hipGetErrorString(e), grid);
#endif
}
```

```cpp
#include <hip/hip_runtime.h>
#include <hip/hip_cooperative_groups.h>
#include <cstdio>
namespace cg = cooperative_groups;

#define DBG_LAST 21
#define DBG_SKIP 0x0
#ifndef DBG_DOUBLE
#define DBG_DOUBLE 0x0
#endif
#define DRY(rep) ((((DBG_DOUBLE >> kind) & 1) != 0) && (rep) == 0)
#ifndef MULTI_LAUNCH
#define MULTI_LAUNCH 0
#endif

#ifndef ONLY
#define ONLY -1
#endif
#define EN(k) (ONLY == -1 || ONLY == (k))
#define DI __device__ __forceinline__
#define LAS __attribute__((address_space(3)))
typedef unsigned short bf16_t;
typedef short bf16x8 __attribute__((ext_vector_type(8)));
typedef short s16x4 __attribute__((ext_vector_type(4)));
typedef float f32x4 __attribute__((ext_vector_type(4)));
typedef float f32x16 __attribute__((ext_vector_type(16)));
typedef unsigned u32x4 __attribute__((ext_vector_type(4)));
typedef unsigned u32x2 __attribute__((ext_vector_type(2)));

constexpr int MREG = 32768;
constexpr int RCONT = MREG + 64;
constexpr size_t RALLOC = MREG + 128;
constexpr size_t WS_HMETA = 0;
constexpr size_t WS_BIAS = 65536;
constexpr size_t WS_OMETA = 65536 + 8192;
constexpr size_t WS_BAR = 196608;
constexpr size_t WS_WIN = 262144;
constexpr size_t WS_WOUT = WS_WIN + 16777216;
constexpr size_t WS_WG = WS_WOUT + 4194304;
constexpr size_t WS_HN = WS_WG + 32768;
constexpr size_t WS_ACT = WS_HN + RALLOC * 2048;
constexpr size_t WS_ATTN = WS_ACT + RALLOC * 12288;
constexpr size_t WS_E = WS_ATTN + (size_t)513 * 4 * 4096 * 2;
constexpr size_t WS_GLR = WS_E + (size_t)513 * 4 * 256 * 4;
constexpr size_t WS_END = WS_GLR + RALLOC * 64;
constexpr int LDS_BYTES = 147456;
constexpr int NPHASES = 23;

struct Params {
    const float *x, *meta, *g_norm, *gla_w_in, *gla_wgu, *gla_bg, *gla_gn, *gla_w_out, *diff_w_in, *diff_lam, *diff_gn, *diff_w_out, *rel_bias, *g_final;
    float* out; unsigned char* ws; int ph_lo, ph_hi;
};

DI int opaque_bid() { int b = blockIdx.x; asm volatile("" : "+s"(b)); return b; }
DI int opaque_gdim() { int g = gridDim.x; asm volatile("" : "+s"(g)); return g; }
DI int hw_lane() { unsigned z = 0u; asm volatile("" : "+s"(z)); return (int)__builtin_amdgcn_mbcnt_hi(~0u, __builtin_amdgcn_mbcnt_lo(~0u, z)); }
DI int opaque_tid(int wid0) { int w = wid0; asm volatile("" : "+s"(w)); return w * 64 + hw_lane(); }
typedef __bf16 bf16v2_t __attribute__((ext_vector_type(2)));
typedef float f32x2_t __attribute__((ext_vector_type(2)));
DI unsigned cvt_pk_bf16(float lo, float hi) { const f32x2_t v = {lo, hi}; const bf16v2_t b = __builtin_convertvector(v, bf16v2_t); return __builtin_bit_cast(unsigned, b); }
DI float bf2f(short b) { return __uint_as_float(((unsigned)(unsigned short)b) << 16); }
#define SWZ_XOR(v, x) __int_as_float(__builtin_amdgcn_ds_swizzle(__float_as_int(v), 0x1F | ((x) << 10)))
DI float half_sum(float v) { v += SWZ_XOR(v, 1); v += SWZ_XOR(v, 2); v += SWZ_XOR(v, 4); v += SWZ_XOR(v, 8); v += SWZ_XOR(v, 16); return v; }
DI float wave_sum(float v) { v = half_sum(v); auto rr = __builtin_amdgcn_permlane32_swap(__float_as_uint(v), __float_as_uint(v), false, false); return __uint_as_float(rr[0]) + __uint_as_float(rr[1]); }
DI int crow(int r, int hi) { return (r & 3) + 8 * (r >> 2) + 4 * hi; }
#define MFMA16(a, b, c) __builtin_amdgcn_mfma_f32_16x16x32_bf16((a), (b), (c), 0, 0, 0)
#define MFMA32(a, b, c) __builtin_amdgcn_mfma_f32_32x32x16_bf16((a), (b), (c), 0, 0, 0)

namespace pg8 {
constexpr int BM = 256, BK = 64, HALF = 128, HTB = HALF * BK * 2, STAGE_BYTES = 8 * HTB, NXCD = 8, WGM = 8;
DI int lds_byte(int r, int c) { const int st = (r >> 4) * 2 + (c >> 5), rr = r & 15, cc = c & 31, ob = rr * 64 + cc * 2; return st * 1024 + (ob ^ (((ob >> 9) & 1) << 5)); }
DI void stage_rc(int b, int& R, int& C) { const int st = b / 1024, sb = b % 1024, swz = sb ^ (((sb >> 9) & 1) << 5); R = (st >> 1) * 16 + swz / 64; C = (st & 1) * 32 + (swz % 64) / 2; }
DI int perm32(int rho) { const int n = rho >> 4, i = rho & 15; return 8 * (i >> 2) + 4 * n + (i & 3); }
struct Unit { int pm, pn; };
struct Gemm { const bf16_t* A; const bf16_t* Bt; int M, N, K; };
struct StaticOrder {
    int nM, nN, nwg, G, c;
    DI void init(int M, int N, int G_, int c_) { nM = M / BM; nN = N / BM; nwg = nM * nN; G = G_; c = c_; }
    DI bool next(int i, Unit& u) const {
        const long L = (long)i * G + c; if (L >= nwg) return false;
        int wgid = (int)L; { const int q = nwg / NXCD, r = nwg % NXCD, xcd = wgid % NXCD, off = wgid / NXCD; wgid = (xcd < r ? xcd * (q + 1) : r * (q + 1) + (xcd - r) * q) + off; }
        const int nig = WGM * nN, gid = wgid / nig, fm = gid * WGM, gsz = (nM - fm) < WGM ? (nM - fm) : WGM;
        u.pm = fm + ((wgid % nig) % gsz); u.pn = (wgid % nig) / gsz; return true;
    }
};
template <class F> struct EpiGen {
    F f;
    DI void operator()(const f32x4 (&acc)[2][2][4][2], const Unit& u, int wr, int wc, int fr, int fq) const {
        const int row0 = u.pm * BM + wr * 64 + fr, col0 = u.pn * BM + wc * 32 + 8 * fq;
#pragma unroll
        for (int ai = 0; ai < 2; ++ai)
#pragma unroll
            for (int m = 0; m < 4; ++m)
#pragma unroll
                for (int bj = 0; bj < 2; ++bj) f.store8(row0 + ai * HALF + m * 16, col0 + bj * HALF, acc[ai][bj][m][0], acc[ai][bj][m][1]);
    }
};

template <class Epi>
DI void gemm_phase(int wid0, LAS unsigned char* lds, const Gemm g, const StaticOrder& S, const Epi& E) {
    const int tid = opaque_tid(wid0), wid = __builtin_amdgcn_readfirstlane(tid >> 6), lane = tid & 63, wr = wid >> 2, wc = wid & 3, fr = lane & 15, fq = lane >> 4;
    const int K = g.K, nt = K / BK;
    unsigned voffA[2], voffB[2];
#pragma unroll
    for (int i = 0; i < 2; ++i) { int R, C; stage_rc(tid * 16 + i * 8192, R, C); const int Rb = (R & ~31) + perm32(R & 31); voffA[i] = (unsigned)(R * K + C) * 2u; voffB[i] = (unsigned)(Rb * K + C) * 2u; }
    const size_t kstep = (size_t)(BK * 2);
    const size_t hstep = (size_t)HALF * K * 2;
    const size_t tstep = 2 * hstep;
    const unsigned ldsw = (unsigned)wid * 1024u;
    const int aoff = lds_byte(wr * 64 + fr, fq * 8), boff = lds_byte(wc * 32 + fr, fq * 8);
#define PG8_SA(b, h) (((b) * 2 + (h)) * HTB)
#define PG8_SB(b, h) ((4 + (b) * 2 + (h)) * HTB)
#define PG8_STAGE(bufoff, gbase, voff) do { _Pragma("unroll") for (int _i = 0; _i < 2; ++_i) \
        __builtin_amdgcn_global_load_lds((const unsigned*)((const char*)(gbase) + (voff)[_i]), (LAS unsigned*)(lds + (bufoff) + ldsw + _i * 8192), 16, 0, 0); } while (0)
#define PG8_LDA(dst, b, h) do { _Pragma("unroll") for (int m = 0; m < 4; ++m) _Pragma("unroll") for (int k = 0; k < 2; ++k) dst[m][k] = *(const LAS bf16x8*)(lds + PG8_SA(b, h) + aoff + m * 2048 + k * 1024); } while (0)
#define PG8_LDB(dst, b, h) do { _Pragma("unroll") for (int n = 0; n < 2; ++n) _Pragma("unroll") for (int k = 0; k < 2; ++k) dst[n][k] = *(const LAS bf16x8*)(lds + PG8_SB(b, h) + boff + n * 2048 + k * 1024); } while (0)
#define PG8_MMA(ai, bj, At, Bt) do { __builtin_amdgcn_s_setprio(1); _Pragma("unroll") for (int m = 0; m < 4; ++m) _Pragma("unroll") for (int n = 0; n < 2; ++n) _Pragma("unroll") for (int k = 0; k < 2; ++k) \
        acc[ai][bj][m][n] = __builtin_amdgcn_mfma_f32_16x16x32_bf16(Bt[n][k], At[m][k], acc[ai][bj][m][n], 0, 0, 0); __builtin_amdgcn_s_setprio(0); } while (0)
#define PG8_WAIT_V(n) asm volatile("s_waitcnt vmcnt(" #n ")" ::: "memory")
#define PG8_WAIT_L(n) asm volatile("s_waitcnt lgkmcnt(" #n ")" ::: "memory")
#define PG8_BAR __builtin_amdgcn_s_barrier()
#define PG8_SCHED __builtin_amdgcn_sched_barrier(0)
    Unit cur, nxt; int ui = 0;
    if (!S.next(0, cur)) return;
    f32x4 acc[2][2][4][2];
#pragma unroll
    for (int a = 0; a < 2; ++a)
#pragma unroll
        for (int b = 0; b < 2; ++b)
#pragma unroll
            for (int m = 0; m < 4; ++m)
#pragma unroll
                for (int n = 0; n < 2; ++n) acc[a][b][m][n] = (f32x4){0.f, 0.f, 0.f, 0.f};
    bf16x8 At[4][2], B0[2][2], B1[2][2];
    const char* cA = (const char*)g.A + (size_t)cur.pm * tstep; const char* cB = (const char*)g.Bt + (size_t)cur.pn * tstep;
    PG8_STAGE(PG8_SB(0, 0), cB, voffB); PG8_STAGE(PG8_SB(0, 1), cB + hstep, voffB); PG8_STAGE(PG8_SA(0, 0), cA, voffA); PG8_STAGE(PG8_SA(0, 1), cA + hstep, voffA);
    if (wr == 1) PG8_BAR;
    PG8_WAIT_V(2); PG8_BAR;
    PG8_STAGE(PG8_SB(1, 0), cB + kstep, voffB); PG8_STAGE(PG8_SA(1, 0), cA + kstep, voffA); PG8_STAGE(PG8_SB(1, 1), cB + hstep + kstep, voffB);
    PG8_WAIT_V(6); PG8_BAR;
    for (;;) {
        const bool has_next = S.next(ui + 1, nxt);
        const char* nA = has_next ? (const char*)g.A + (size_t)nxt.pm * tstep : cA; const char* nB = has_next ? (const char*)g.Bt + (size_t)nxt.pn * tstep : cB;
        for (int t = 0; t < nt; t += 2) {
            const bool last = (t == nt - 2);
            const char* a1 = cA + (size_t)(t + 1) * kstep;
            const char* a2 = last ? nA : cA + (size_t)(t + 2) * kstep; const char* b2 = last ? nB : cB + (size_t)(t + 2) * kstep;
            const char* a3 = a2 + kstep; const char* b3 = b2 + kstep;
            PG8_LDB(B0, 0, 0); PG8_LDB(B1, 0, 1); PG8_SCHED; PG8_LDA(At, 0, 0); PG8_STAGE(PG8_SA(1, 1), a1 + hstep, voffA);
            PG8_WAIT_V(8); PG8_WAIT_L(0); PG8_BAR; PG8_MMA(0, 0, At, B0); PG8_MMA(0, 1, At, B1); PG8_BAR; PG8_SCHED;
            PG8_LDA(At, 0, 1); PG8_STAGE(PG8_SB(0, 0), b2, voffB); PG8_STAGE(PG8_SB(0, 1), b2 + hstep, voffB); PG8_STAGE(PG8_SA(0, 0), a2, voffA);
            PG8_WAIT_V(8); PG8_WAIT_L(0); PG8_BAR; PG8_MMA(1, 0, At, B0); PG8_MMA(1, 1, At, B1); PG8_BAR; PG8_SCHED;
            PG8_LDB(B0, 1, 0); PG8_LDB(B1, 1, 1); PG8_SCHED; PG8_LDA(At, 1, 0); PG8_STAGE(PG8_SA(0, 1), a2 + hstep, voffA);
            PG8_WAIT_V(8); PG8_WAIT_L(0); PG8_BAR; PG8_MMA(0, 0, At, B0); PG8_MMA(0, 1, At, B1); PG8_BAR; PG8_SCHED;
            PG8_LDA(At, 1, 1); PG8_STAGE(PG8_SB(1, 0), b3, voffB); PG8_STAGE(PG8_SB(1, 1), b3 + hstep, voffB); PG8_STAGE(PG8_SA(1, 0), a3, voffA);
            PG8_WAIT_V(8); PG8_WAIT_L(0); PG8_BAR; PG8_MMA(1, 0, At, B0); PG8_MMA(1, 1, At, B1); PG8_BAR; PG8_SCHED;
        }
        if (wr == 0) PG8_BAR;
        E(acc, cur, wr, wc, fr, fq);
        if (!has_next) break;
#pragma unroll
        for (int a = 0; a < 2; ++a)
#pragma unroll
            for (int b = 0; b < 2; ++b)
#pragma unroll
                for (int m = 0; m < 4; ++m)
#pragma unroll
                    for (int n = 0; n < 2; ++n) acc[a][b][m][n] = (f32x4){0.f, 0.f, 0.f, 0.f};
        cur = nxt; cA = nA; cB = nB; ++ui;
        if (wr == 1) PG8_BAR;
    }
    PG8_WAIT_V(0);
    PG8_BAR;
#undef PG8_SA
#undef PG8_SB
#undef PG8_STAGE
#undef PG8_LDA
#undef PG8_LDB
#undef PG8_MMA
#undef PG8_WAIT_V
#undef PG8_WAIT_L
#undef PG8_BAR
#undef PG8_SCHED
}
}

struct StGlaIn {
    bf16_t* act;
    DI void operator()(int row, int col, f32x4 a) const {
        bf16_t* d;
        if (col < 1024) d = act + (size_t)row * 1024 + col;
        else if (col < 2048) d = act + RALLOC * 1024 + (size_t)row * 1024 + (col - 1024);
        else if (col < 4096) d = act + RALLOC * 2048 + (size_t)row * 2048 + (col - 2048);
        else d = act + RALLOC * 4096 + (size_t)row * 2048 + (col - 4096);
        u32x2 w; w.x = cvt_pk_bf16(a[0], a[1]); w.y = cvt_pk_bf16(a[2], a[3]); *(u32x2*)d = w;
    }
    DI void store8(int row, int col, f32x4 a, f32x4 b) const {
        bf16_t* d;
        if (col < 1024) d = act + (size_t)row * 1024 + col;
        else if (col < 2048) d = act + RALLOC * 1024 + (size_t)row * 1024 + (col - 1024);
        else if (col < 4096) d = act + RALLOC * 2048 + (size_t)row * 2048 + (col - 2048);
        else d = act + RALLOC * 4096 + (size_t)row * 2048 + (col - 4096);
        u32x4 w; w.x = cvt_pk_bf16(a[0], a[1]); w.y = cvt_pk_bf16(a[2], a[3]); w.z = cvt_pk_bf16(b[0], b[1]); w.w = cvt_pk_bf16(b[2], b[3]); *(u32x4*)d = w;
    }
};
struct StDiffIn {
    bf16_t* act;
    DI void operator()(int row, int col, f32x4 a) const {
        bf16_t* d = act + (size_t)(col >> 11) * (RALLOC * 2048) + (size_t)row * 2048 + (col & 2047);
        u32x2 w; w.x = cvt_pk_bf16(a[0], a[1]); w.y = cvt_pk_bf16(a[2], a[3]); *(u32x2*)d = w;
    }
    DI void store8(int row, int col, f32x4 a, f32x4 b) const {
        bf16_t* d = act + (size_t)(col >> 11) * (RALLOC * 2048) + (size_t)row * 2048 + (col & 2047);
        u32x4 w; w.x = cvt_pk_bf16(a[0], a[1]); w.y = cvt_pk_bf16(a[2], a[3]); w.z = cvt_pk_bf16(b[0], b[1]); w.w = cvt_pk_bf16(b[2], b[3]); *(u32x4*)d = w;
    }
};
struct StZGate {
    bf16_t* o; bool dry;
    DI void operator()(int row, int col, f32x4 a) const {
        bf16_t* d = o + (size_t)row * 2048 + col;
        const u32x2 ov = *(const u32x2*)d;
        float of[4] = {__uint_as_float(ov.x << 16), __uint_as_float(ov.x & 0xffff0000u), __uint_as_float(ov.y << 16), __uint_as_float(ov.y & 0xffff0000u)};
        float y[4];
#pragma unroll
        for (int i = 0; i < 4; ++i) { const float z = a[i]; y[i] = z * __builtin_amdgcn_rcpf(1.f + __expf(-z)) * of[i]; }
        u32x2 w; w.x = cvt_pk_bf16(y[0], y[1]); w.y = cvt_pk_bf16(y[2], y[3]); if (!dry) *(u32x2*)d = w;
    }
    DI void store8(int row, int col, f32x4 a, f32x4 b) const {
        bf16_t* d = o + (size_t)row * 2048 + col;
        const u32x4 ov = *(const u32x4*)d;
        const unsigned ow[4] = {ov.x, ov.y, ov.z, ov.w}; float y[8];
#pragma unroll
        for (int i = 0; i < 8; ++i) { const float z = i < 4 ? a[i] : b[i - 4]; const float of = (i & 1) ? __uint_as_float(ow[i >> 1] & 0xffff0000u) : __uint_as_float(ow[i >> 1] << 16); y[i] = z * __builtin_amdgcn_rcpf(1.f + __expf(-z)) * of; }
        u32x4 w; w.x = cvt_pk_bf16(y[0], y[1]); w.y = cvt_pk_bf16(y[2], y[3]); w.z = cvt_pk_bf16(y[4], y[5]); w.w = cvt_pk_bf16(y[6], y[7]); if (!dry) *(u32x4*)d = w;
    }
};
struct StResid {
    const float* src; float* dst; int rowoff; bool dry;
    DI void operator()(int row, int col, f32x4 a) const {
        const size_t o = (size_t)(row - rowoff) * 1024 + col;
        const f32x4 s = *(const f32x4*)(src + o); if (!dry) *(f32x4*)(dst + o) = s + a;
    }
    DI void store8(int row, int col, f32x4 a, f32x4 b) const {
        const size_t o = (size_t)(row - rowoff) * 1024 + col;
        const f32x4 s0 = *(const f32x4*)(src + o), s1 = *(const f32x4*)(src + o + 4);
        if (!dry) { *(f32x4*)(dst + o) = s0 + a; *(f32x4*)(dst + o + 4) = s1 + b; }
    }
};
struct StGlr {
    float* glr;
    DI void operator()(int row, int col, f32x4 a) const { *(f32x4*)(glr + (size_t)row * 16 + col) = a; }
};

template <class St>
DI void mini_gemm(int wid0, const bf16_t* A, int lda, int arow0, int nrt, const bf16_t* Bt, int K, int N, const St& st) {
    const int tid_ = opaque_tid(wid0), lane = tid_ & 63, wave = tid_ >> 6, nw = opaque_gdim() * 8, nct = N / 16;
    const int gw = (wave * opaque_gdim() + opaque_bid());
    for (int t = gw; t < nrt * nct; t += nw) {
        const int rt = t % nrt, ct = t / nrt;
        const bf16_t* ap = A + (size_t)(arow0 + rt * 16 + (lane & 15)) * lda + 8 * (lane >> 4);
        const bf16_t* bp = Bt + (size_t)(ct * 16 + (lane & 15)) * K + 8 * (lane >> 4);
        f32x4 acc0 = (f32x4){0.f, 0.f, 0.f, 0.f}, acc1 = (f32x4){0.f, 0.f, 0.f, 0.f};
        for (int k0 = 0; k0 < K; k0 += 256) {
            bf16x8 a[8], b[8];
#pragma unroll
            for (int j = 0; j < 8; ++j) { a[j] = *(const bf16x8*)(ap + k0 + 32 * j); b[j] = *(const bf16x8*)(bp + k0 + 32 * j); }
#pragma unroll
            for (int j = 0; j < 8; j += 2) { acc0 = MFMA16(b[j], a[j], acc0); acc1 = MFMA16(b[j + 1], a[j + 1], acc1); }
        }
        st(arow0 + rt * 16 + (lane & 15), ct * 16 + 4 * (lane >> 4), acc0 + acc1);
    }
}
DI void glr_gemm(int wid0, const bf16_t* hn, const bf16_t* WgT, float* glr) {
    const int tid_ = opaque_tid(wid0), lane = tid_ & 63, wave = tid_ >> 6, nw = opaque_gdim() * 8;
    const int gw = ((7 - wave) * opaque_gdim() + opaque_bid());
    for (int t = gw; t < RCONT / 64; t += nw) {
        const bf16_t* ap = hn + (size_t)(t * 64 + (lane & 15)) * 1024 + 8 * (lane >> 4);
        const bf16_t* bp = WgT + (size_t)(lane & 15) * 1024 + 8 * (lane >> 4);
        f32x4 acc[4];
#pragma unroll
        for (int c = 0; c < 4; ++c) acc[c] = (f32x4){0.f, 0.f, 0.f, 0.f};
#pragma unroll 4
        for (int k0 = 0; k0 < 1024; k0 += 32) {
            const bf16x8 b = *(const bf16x8*)(bp + k0);
#pragma unroll
            for (int c = 0; c < 4; ++c) { const bf16x8 a = *(const bf16x8*)(ap + (size_t)c * 16 * 1024 + k0); acc[c] = MFMA16(b, a, acc[c]); }
        }
#pragma unroll
        for (int c = 0; c < 4; ++c) *(f32x4*)(glr + (size_t)(t * 64 + c * 16 + (lane & 15)) * 16 + 4 * (lane >> 4)) = acc[c];
    }
}

DI void phase_bias(int wid0, const Params& p) {
    float* T = (float*)(p.ws + WS_BIAS);
    const int i = opaque_bid() * 512 + opaque_tid(wid0);
    if (i < 8 * 129) {
        const int h = i / 129, n = i % 129; int bucket;
        if (n < 16) bucket = n;
        else { const float nf = (float)n; int lg = 16 + (int)(logf(nf / 16.f) / logf(8.f) * 16.f); bucket = lg < 31 ? lg : 31; }
        T[i] = p.rel_bias[bucket * 8 + h] * 1.4426950408889634f;
    }
}
DI void phase_norm(int wid0, const Params& p, int L) {
    const float* hreg = (L == 0) ? p.x : p.out; const float* hmeta = (L == 0) ? p.meta : (const float*)(p.ws + WS_HMETA);
    const float* g = p.g_norm + L * 1024; bf16_t* hn = (bf16_t*)(p.ws + WS_HN);
    const int tid_ = opaque_tid(wid0), wave = tid_ >> 6, lane = tid_ & 63, stride = opaque_gdim() * 8;
    f32x4 gv[4];
#pragma unroll
    for (int i = 0; i < 4; ++i) gv[i] = *(const f32x4*)(g + i * 256 + lane * 4);
    for (int row0 = opaque_bid() * 8 + wave; row0 < RCONT; row0 += 2 * stride) {
        f32x4 v[2][4]; float ss[2] = {0.f, 0.f};
#pragma unroll
        for (int q = 0; q < 2; ++q) {
            const int row = row0 + q * stride;
            if (row < MREG + 16) {
                const float* src = row < MREG ? hreg + (size_t)row * 1024 : hmeta + (size_t)(row - MREG) * 1024;
#pragma unroll
                for (int i = 0; i < 4; ++i) v[q][i] = *(const f32x4*)(src + i * 256 + lane * 4);
            } else {
#pragma unroll
                for (int i = 0; i < 4; ++i) v[q][i] = (f32x4){0.f, 0.f, 0.f, 0.f};
            }
        }
#pragma unroll
        for (int q = 0; q < 2; ++q) {
#pragma unroll
            for (int i = 0; i < 4; ++i) ss[q] += v[q][i][0] * v[q][i][0] + v[q][i][1] * v[q][i][1] + v[q][i][2] * v[q][i][2] + v[q][i][3] * v[q][i][3];
            ss[q] = wave_sum(ss[q]);
        }
#pragma unroll
        for (int q = 0; q < 2; ++q) {
            const int row = row0 + q * stride;
            if (row < RCONT) {
                const float rstd = rsqrtf(ss[q] * (1.f / 1024.f) + 1e-6f);
                bf16_t* dst = hn + (size_t)row * 1024;
#pragma unroll
                for (int i = 0; i < 4; ++i) {
                    u32x2 w; w.x = cvt_pk_bf16(v[q][i][0] * rstd * gv[i][0], v[q][i][1] * rstd * gv[i][1]); w.y = cvt_pk_bf16(v[q][i][2] * rstd * gv[i][2], v[q][i][3] * rstd * gv[i][3]);
                    *(u32x2*)(dst + i * 256 + lane * 4) = w;
                }
            }
        }
    }
}
DI void phase_final(int wid0, const Params& p) {
    const int tid_ = opaque_tid(wid0), wave = tid_ >> 6, lane = tid_ & 63;
    for (int row = opaque_bid() * 8 + wave; row < MREG; row += opaque_gdim() * 8) {
        float* src = p.out + (size_t)row * 1024;
        f32x4 v[4]; float ss = 0.f;
#pragma unroll
        for (int i = 0; i < 4; ++i) { v[i] = *(const f32x4*)(src + i * 256 + lane * 4); ss += v[i][0] * v[i][0] + v[i][1] * v[i][1] + v[i][2] * v[i][2] + v[i][3] * v[i][3]; }
        ss = wave_sum(ss);
        const float rstd = rsqrtf(ss * (1.f / 1024.f) + 1e-6f);
#pragma unroll
        for (int i = 0; i < 4; ++i) { const f32x4 gv = *(const f32x4*)(p.g_final + i * 256 + lane * 4); *(f32x4*)(src + i * 256 + lane * 4) = v[i] * rstd * gv; }
    }
}
DI void wconv_tile(const float* W, int ldw, int K, bf16_t* Bt, int k0, int n0, float* tile, int lane) {
#pragma unroll
    for (int i = 0; i < 16; ++i) {
        const int k = (lane >> 4) + 4 * i, n4 = (lane & 15) * 4;
        const f32x4 v = *(const f32x4*)(W + (size_t)(k0 + k) * ldw + n0 + n4);
        tile[k * 65 + n4] = v[0]; tile[k * 65 + n4 + 1] = v[1]; tile[k * 65 + n4 + 2] = v[2]; tile[k * 65 + n4 + 3] = v[3];
    }
    asm volatile("s_waitcnt lgkmcnt(0)" ::: "memory");
#pragma unroll
    for (int i = 0; i < 8; ++i) {
        const int n = (lane >> 3) + 8 * i, k8 = (lane & 7) * 8;
        float e[8];
#pragma unroll
        for (int j = 0; j < 8; ++j) e[j] = tile[(k8 + j) * 65 + n];
        u32x4 w; w.x = cvt_pk_bf16(e[0], e[1]); w.y = cvt_pk_bf16(e[2], e[3]); w.z = cvt_pk_bf16(e[4], e[5]); w.w = cvt_pk_bf16(e[6], e[7]);
        *(u32x4*)(Bt + (size_t)(n0 + n) * K + k0 + k8) = w;
    }
    asm volatile("s_waitcnt lgkmcnt(0)" ::: "memory");
}
DI void wconv_all(int wid0, const float* Win, int Nmain, int ldw, bf16_t* win, const float* Wout, bf16_t* wout, unsigned char* lds) {
    const int tid = opaque_tid(wid0), lane = tid & 63, wave = tid >> 6, nw = opaque_gdim() * 8;
    float* tile = (float*)(lds + wave * 16640);
    const int t1 = 16 * (Nmain / 64), ttot = t1 + 32 * 16;
    for (int t = wave * opaque_gdim() + opaque_bid(); t < ttot; t += nw) {
        if (t < t1) wconv_tile(Win, ldw, 1024, win, (t & 15) * 64, (t >> 4) * 64, tile, lane);
        else { const int u = t - t1; wconv_tile(Wout, 1024, 2048, wout, (u & 31) * 64, (u >> 5) * 64, tile, lane); }
    }
}
DI void phase_wconv(int wid0, const Params& p, int L, unsigned char* lds) {
    const int li = L >> 1;
    bf16_t* win = (bf16_t*)(p.ws + WS_WIN); bf16_t* wout = (bf16_t*)(p.ws + WS_WOUT); bf16_t* wg = (bf16_t*)(p.ws + WS_WG);
    if ((L & 1) == 0) {
        const float* W = p.gla_w_in + (size_t)li * 1024 * 6160;
        wconv_all(wid0, W, 6144, 6160, win, p.gla_w_out + (size_t)li * 2048 * 1024, wout, lds);
        for (int i = opaque_bid() * 512 + opaque_tid(wid0); i < 16 * 1024; i += opaque_gdim() * 512) { const int r = i >> 10, k = i & 1023; wg[i] = (bf16_t)(cvt_pk_bf16(W[(size_t)k * 6160 + 6144 + r], 0.f) & 0xffffu); }
    } else {
        wconv_all(wid0, p.diff_w_in + (size_t)li * 1024 * 8192, 8192, 8192, win, p.diff_w_out + (size_t)li * 2048 * 1024, wout, lds);
    }
}

DI void phase_prep(int wid0, const Params& p, int L, unsigned char* lds, bool dry) {
    const int gi = L >> 1, tid = opaque_tid(wid0), wave = tid >> 6, lane = tid & 63, r32 = lane & 31, hi = lane >> 5;
    const float* wgu = p.gla_wgu + (size_t)gi * 16 * 1024; const float* bg = p.gla_bg + (size_t)gi * 1024;
    bf16_t* act = (bf16_t*)(p.ws + WS_ACT); bf16_t* qb = act; bf16_t* kb = act + RALLOC * 1024;
    bf16_t* khT = (bf16_t*)(p.ws + WS_HN); bf16_t* attn = (bf16_t*)(p.ws + WS_ATTN); float* Eo = (float*)(p.ws + WS_E); const float* glr = (const float*)(p.ws + WS_GLR);
    float* bs = (float*)lds; float* tot = (float*)(lds + 65536); float* gl = (float*)(lds + 67584); bf16_t* qs = (bf16_t*)(lds + 71680); bf16_t* xs = (bf16_t*)(lds + 105472);
    for (int u = opaque_bid(); u < 513 * 4; u += opaque_gdim()) {
        const int g = u >> 2, hd = u & 3; const bool ismeta = (g == 512); const int row0 = ismeta ? MREG : g * 64;
        for (int i = tid; i < 1024; i += 512) gl[i] = glr[(size_t)row0 * 16 + i];
        bf16x8 qreg[4], kreg[4];
#pragma unroll
        for (int it = 0; it < 4; ++it) {
            const int gid = tid + 512 * it, i = gid >> 5, d8 = (gid & 31) * 8;
            const size_t goff = (size_t)(row0 + i) * 1024 + hd * 256 + d8;
            qreg[it] = *(const bf16x8*)(qb + goff); kreg[it] = *(const bf16x8*)(kb + goff);
        }
        __syncthreads();
        {
            const int d = tid & 255, ih = tid >> 8; float w[16];
#pragma unroll
            for (int r = 0; r < 16; ++r) w[r] = wgu[r * 1024 + hd * 256 + d];
            const float bgd = bg[hd * 256 + d]; float run = 0.f;
            for (int ii = 0; ii < 32; ++ii) {
                const int i = ih * 32 + ii; float x = bgd;
                const f32x4 g0 = *(const f32x4*)(gl + i * 16), g1 = *(const f32x4*)(gl + i * 16 + 4), g2 = *(const f32x4*)(gl + i * 16 + 8), g3 = *(const f32x4*)(gl + i * 16 + 12);
#pragma unroll
                for (int r = 0; r < 4; ++r) { x = fmaf(g0[r], w[r], x); x = fmaf(g1[r], w[4 + r], x); x = fmaf(g2[r], w[8 + r], x); x = fmaf(g3[r], w[12 + r], x); }
                float lgv = (fminf(x, 0.f) - __logf(1.f + __expf(-fabsf(x)))) * 0.0625f;
                if (ismeta && i >= 16) lgv = 0.f;
                run += lgv; bs[i * 256 + d] = run;
            }
            tot[ih * 256 + d] = run;
        }
        asm volatile("s_waitcnt vmcnt(0)" ::: "memory");
        __syncthreads();
#pragma unroll
        for (int it = 0; it < 4; ++it) {
            const int gid = tid + 512 * it, i = gid >> 5, d8 = (gid & 31) * 8;
            const bf16x8 qv = qreg[it]; const bf16x8 kv = kreg[it];
            float qt[8];
            const f32x4 bsv[2] = {*(const f32x4*)(bs + i * 256 + d8), *(const f32x4*)(bs + i * 256 + d8 + 4)};
            const f32x4 t0v[2] = {*(const f32x4*)(tot + d8), *(const f32x4*)(tot + d8 + 4)};
            const f32x4 t1v[2] = {*(const f32x4*)(tot + 256 + d8), *(const f32x4*)(tot + 256 + d8 + 4)};
#pragma unroll
            for (int e = 0; e < 8; ++e) {
                const float b = bsv[e >> 2][e & 3] + (i >= 32 ? t0v[e >> 2][e & 3] : 0.f); const float bl = t0v[e >> 2][e & 3] + t1v[e >> 2][e & 3];
                qt[e] = bf2f(qv[e]) * 0.0625f * __expf(b);
                const float kh = bf2f(kv[e]) * __expf(bl - b);
                xs[(d8 + e) * 64 + (i ^ (2 * ((d8 >> 3) & 31)))] = (bf16_t)(cvt_pk_bf16(kh, 0.f) & 0xffffu);
            }
            u32x4 w; w.x = cvt_pk_bf16(qt[0], qt[1]); w.y = cvt_pk_bf16(qt[2], qt[3]); w.z = cvt_pk_bf16(qt[4], qt[5]); w.w = cvt_pk_bf16(qt[6], qt[7]);
            {
                const int ob = (((i >> 4) * 8 + (d8 >> 5)) * 64 + ((d8 & 31) >> 3) * 16 + (i & 15)) * 16;
                *(u32x4*)(qb + (size_t)(row0 + (ob >> 9)) * 1024 + hd * 256 + ((ob & 511) >> 1)) = w;
            }
            *(u32x4*)(qs + i * 264 + d8) = w;
        }
        __syncthreads();
#pragma unroll
        for (int it = 0; it < 4; ++it) {
            const int gid = tid + 512 * it, d = gid >> 3, j8 = gid & 7, sw = (d >> 3) & 31;
            u32x4 w = *(const u32x4*)(xs + d * 64 + ((j8 ^ (sw >> 2)) * 8));
            if (sw & 1) w = (u32x4){w.y, w.x, w.w, w.z};
            if (sw & 2) w = (u32x4){w.z, w.w, w.x, w.y};
            *(u32x4*)(khT + (size_t)u * 16384 + ((((d >> 5) * 4 + (j8 >> 1)) * 64 + (j8 & 1) * 32 + (d & 31)) * 8)) = w;
        }
        if (tid < 256) Eo[(size_t)u * 256 + tid] = __expf(tot[tid] + tot[256 + tid]);
        __syncthreads();
#pragma unroll
        for (int it = 0; it < 4; ++it) {
            const int gid = tid + 512 * it, i = gid >> 5, d8 = (gid & 31) * 8; float kt[8];
            const f32x4 bsv[2] = {*(const f32x4*)(bs + i * 256 + d8), *(const f32x4*)(bs + i * 256 + d8 + 4)};
            const f32x4 t0v[2] = {*(const f32x4*)(tot + d8), *(const f32x4*)(tot + d8 + 4)};
#pragma unroll
            for (int e = 0; e < 8; ++e) { const float b = bsv[e >> 2][e & 3] + (i >= 32 ? t0v[e >> 2][e & 3] : 0.f); kt[e] = bf2f(kreg[it][e]) * __expf(-b); }
            u32x4 w; w.x = cvt_pk_bf16(kt[0], kt[1]); w.y = cvt_pk_bf16(kt[2], kt[3]); w.z = cvt_pk_bf16(kt[4], kt[5]); w.w = cvt_pk_bf16(kt[6], kt[7]);
            *(u32x4*)(xs + i * 264 + d8) = w;
        }
        __syncthreads();
        if (wave < 4) {
            const int ib = wave >> 1, jb = wave & 1; f32x16 acc;
#pragma unroll
            for (int i = 0; i < 16; ++i) acc[i] = 0.f;
            if (!(ib == 0 && jb == 1)) {
#pragma unroll
                for (int s = 0; s < 16; ++s) {
                    const bf16x8 a = *(const bf16x8*)(qs + (32 * ib + r32) * 264 + 16 * s + 8 * hi);
                    const bf16x8 b = *(const bf16x8*)(xs + (32 * jb + r32) * 264 + 16 * s + 8 * hi);
                    acc = MFMA32(a, b, acc);
                }
            }
#pragma unroll
            for (int i = 0; i < 16; ++i) {
                const int row = 32 * ib + crow(i, hi), col = 32 * jb + r32; const float v = (col <= row) ? acc[i] : 0.f;
                attn[(size_t)u * 4096 + ((((row >> 4) * 2 + (col >> 5)) * 64 + ((col & 31) >> 3) * 16 + (row & 15)) * 8) + (col & 7)] = (bf16_t)(cvt_pk_bf16(v, 0.f) & 0xffffu);
            }
        }
        __syncthreads();
    }
}

DI s16x4 tr_read0(unsigned addr) { return __builtin_amdgcn_ds_read_tr16_b64_v4i16((LAS s16x4*)(size_t)addr); }
#define PK8(L, H) (bf16x8){L[0], L[1], L[2], L[3], H[0], H[1], H[2], H[3]}
DI void phase_scan(int wid0, const Params& p, unsigned char* lds, bool dry) {
    const int tid = opaque_tid(wid0), wave = __builtin_amdgcn_readfirstlane(tid >> 6), lane = tid & 63, r32 = lane & 31, hi = lane >> 5, l15 = lane & 15, l4 = lane >> 4;
    bf16_t* act = (bf16_t*)(p.ws + WS_ACT); const bf16_t* qb = act; bf16_t* vb = act + RALLOC * 2048;
    const bf16_t* khT = (const bf16_t*)(p.ws + WS_HN); const bf16_t* attn = (const bf16_t*)(p.ws + WS_ATTN); const float* Eo = (const float*)(p.ws + WS_E);
    bf16_t* ometa = (bf16_t*)(p.ws + WS_OMETA);
    bf16_t* sbt = (bf16_t*)lds; bf16_t* vs = (bf16_t*)(lds + 67584);
    const unsigned vs_base = (unsigned)(size_t)(LAS unsigned char*)(lds + 67584);
    for (int u = opaque_bid(); u < 256; u += opaque_gdim()) {
        const int xcd = u & 7, ix = u >> 3, bh = xcd * 4 + (ix >> 3), vsi = ix & 7, b = bh >> 2, hd = bh & 3, colv = hd * 512 + vsi * 64;
        f32x16 S0, S1;
#pragma unroll
        for (int i = 0; i < 16; ++i) { S0[i] = 0.f; S1[i] = 0.f; }
        for (int i = tid; i < 33792 / 16; i += 512) *(u32x4*)((unsigned char*)sbt + i * 16) = (u32x4){0u, 0u, 0u, 0u};
        const int vj = tid >> 3, vc8 = (tid & 7) * 8;
        u32x4 vnext = *(const u32x4*)(vb + (size_t)(MREG + vj) * 2048 + colv + vc8);
        for (int c = 0; c < 65; ++c) {
            const int g = (c == 0) ? 512 : b * 64 + (c - 1), row0 = (c == 0) ? MREG : g * 64, ug = g * 4 + hd, cur = c & 1;
            *(u32x4*)(vs + cur * 4608 + vj * 72 + vc8) = vnext;
            __syncthreads();
            if (c + 1 < 65) vnext = *(const u32x4*)(vb + (size_t)((b * 64 + c) * 64 + vj) * 2048 + colv + vc8);
            const int ib = wave >> 1, cb0 = 2 * (wave & 1), i = 16 * ib + l15;
            const unsigned vao = vs_base + (unsigned)(cur * 9216 + (8 * l4 + (l15 >> 2)) * 144 + 2 * (16 * cb0 + 4 * (l15 & 3)));
            const unsigned vau = vs_base + (unsigned)(cur * 9216 + (8 * hi + (l15 >> 2)) * 144 + 2 * (16 * ((lane >> 4) & 1) + 4 * (l15 & 3)));
            s16x4 ol[2][2], oh[2][2], ul0[4], uh0[4], ul1[4], uh1[4];
#pragma unroll
            for (int cc = 0; cc < 2; ++cc)
#pragma unroll
                for (int s = 0; s < 2; ++s) { ol[cc][s] = tr_read0(vao + cc * 32 + s * 32 * 144); oh[cc][s] = tr_read0(vao + cc * 32 + s * 32 * 144 + 4 * 144); }
#pragma unroll
            for (int s = 0; s < 2; ++s) {
                ul0[s] = tr_read0(vau + s * 16 * 144); uh0[s] = tr_read0(vau + s * 16 * 144 + 4 * 144);
                ul1[s] = tr_read0(vau + s * 16 * 144 + 64); uh1[s] = tr_read0(vau + s * 16 * 144 + 4 * 144 + 64);
            }
            {
                const bf16_t* ap = attn + (size_t)ug * 4096 + (ib * 2 * 64 + lane) * 8;
                bf16x8 at[2], aq[8];
#pragma unroll
                for (int s = 0; s < 2; ++s) at[s] = *(const bf16x8*)(ap + s * 512);
#pragma unroll
                for (int s = 0; s < 8; ++s) { const int ob = ((ib * 8 + s) * 64 + lane) * 16; aq[s] = *(const bf16x8*)(qb + (size_t)(row0 + (ob >> 9)) * 1024 + hd * 256 + ((ob & 511) >> 1)); }
                __builtin_amdgcn_sched_barrier(0);
                f32x4 oacc[2];
#pragma unroll
                for (int cc = 0; cc < 2; ++cc) {
                    const int cb = cb0 + cc; oacc[cc] = (f32x4){0.f, 0.f, 0.f, 0.f};
#pragma unroll
                    for (int s = 0; s < 2; ++s) oacc[cc] = MFMA16(PK8(ol[cc][s], oh[cc][s]), at[s], oacc[cc]);
                    const bf16_t* sp = sbt + cur * 16896 + (16 * cb + l15) * 264 + 8 * l4;
#pragma unroll
                    for (int s = 0; s < 8; ++s) { const bf16x8 bfr = *(const bf16x8*)(sp + 32 * s); oacc[cc] = MFMA16(bfr, aq[s], oacc[cc]); }
                }
#pragma unroll
                for (int s = 2; s < 4; ++s) {
                    ul0[s] = tr_read0(vau + s * 16 * 144); uh0[s] = tr_read0(vau + s * 16 * 144 + 4 * 144);
                    ul1[s] = tr_read0(vau + s * 16 * 144 + 64); uh1[s] = tr_read0(vau + s * 16 * 144 + 4 * 144 + 64);
                }
#pragma unroll
                for (int cc = 0; cc < 2; ++cc) {
                    const int col = colv + 16 * (cb0 + cc) + 4 * l4;
                    u32x2 w; w.x = cvt_pk_bf16(oacc[cc][0], oacc[cc][1]); w.y = cvt_pk_bf16(oacc[cc][2], oacc[cc][3]);
                    if (dry) {} else if (c > 0) *(u32x2*)(vb + (size_t)(row0 + i) * 2048 + col) = w;
                    else if (b == 0 && i < 16) *(u32x2*)(ometa + (size_t)i * 2048 + col) = w;
                }
            }
            {
                const bf16_t* kp = khT + (size_t)ug * 16384 + (wave * 4 * 64 + lane) * 8;
                bf16x8 kt[4];
#pragma unroll
                for (int s = 0; s < 4; ++s) kt[s] = *(const bf16x8*)(kp + s * 512);
                const float* ep = Eo + (size_t)ug * 256 + 32 * wave + 4 * hi;
#pragma unroll
                for (int g4 = 0; g4 < 4; ++g4) { const f32x4 ev = *(const f32x4*)(ep + 8 * g4);
#pragma unroll
                    for (int j = 0; j < 4; ++j) { S0[4 * g4 + j] *= ev[j]; S1[4 * g4 + j] *= ev[j]; } }
                __builtin_amdgcn_sched_barrier(0);
#pragma unroll
                for (int s = 0; s < 4; ++s) {
                    S0 = MFMA32(kt[s], PK8(ul0[s], uh0[s]), S0);
                    S1 = MFMA32(kt[s], PK8(ul1[s], uh1[s]), S1);
                }
                bf16_t* wp = sbt + (cur ^ 1) * 16896 + r32 * 264 + 32 * wave + 4 * hi;
#pragma unroll
                for (int g4 = 0; g4 < 4; ++g4) {
                    u32x2 w0; w0.x = cvt_pk_bf16(S0[4 * g4], S0[4 * g4 + 1]); w0.y = cvt_pk_bf16(S0[4 * g4 + 2], S0[4 * g4 + 3]);
                    u32x2 w1; w1.x = cvt_pk_bf16(S1[4 * g4], S1[4 * g4 + 1]); w1.y = cvt_pk_bf16(S1[4 * g4 + 2], S1[4 * g4 + 3]);
                    *(u32x2*)(wp + 8 * g4) = w0; *(u32x2*)(wp + 32 * 264 + 8 * g4) = w1;
                }
            }
        }
        __syncthreads();
    }
}

DI void phase_gate(int wid0, const Params& p, int L, bool dry) {
    const int tid_ = opaque_tid(wid0), lane = tid_ & 63, gw = opaque_bid() * 8 + (tid_ >> 6), nw = opaque_gdim() * 8;
    bf16_t* act = (bf16_t*)(p.ws + WS_ACT); const bf16_t* vb = act + RALLOC * 2048; bf16_t* zb = act + RALLOC * 4096; const bf16_t* ometa = (const bf16_t*)(p.ws + WS_OMETA);
    const float* gn = p.gla_gn + (size_t)(L >> 1) * 2048;
    for (int t = gw; t < (MREG + 16) * 4; t += nw) {
        const int row = t >> 2, hd = t & 3;
        const bf16_t* op = row < MREG ? vb + (size_t)row * 2048 + hd * 512 + lane * 8 : ometa + (size_t)(row - MREG) * 2048 + hd * 512 + lane * 8;
        bf16_t* zp = zb + (size_t)row * 2048 + hd * 512 + lane * 8;
        const bf16x8 ov = *(const bf16x8*)op; const bf16x8 zv = *(const bf16x8*)zp;
        float of[8], ss = 0.f;
#pragma unroll
        for (int e = 0; e < 8; ++e) { of[e] = bf2f(ov[e]); ss += of[e] * of[e]; }
        ss = wave_sum(ss);
        const float rstd = rsqrtf(ss * (1.f / 512.f) + 1e-6f);
        const f32x4 g0 = *(const f32x4*)(gn + hd * 512 + lane * 8), g1 = *(const f32x4*)(gn + hd * 512 + lane * 8 + 4);
        float y[8];
#pragma unroll
        for (int e = 0; e < 8; ++e) { const float z = bf2f(zv[e]); y[e] = z * __builtin_amdgcn_rcpf(1.f + __expf(-z)) * of[e] * rstd * (e < 4 ? g0[e] : g1[e - 4]); }
        u32x4 w; w.x = cvt_pk_bf16(y[0], y[1]); w.y = cvt_pk_bf16(y[2], y[3]); w.z = cvt_pk_bf16(y[4], y[5]); w.w = cvt_pk_bf16(y[6], y[7]);
        if (!dry) *(u32x4*)zp = w;
    }
}

constexpr float ATT_C = 0.088388347648318440f * 1.4426950408889634f;
constexpr float ATT_THR2 = 8.f * 1.4426950408889634f;
#define KSWZ(row, colB) ((row) * 256 + ((colB) ^ (((row) & 7) << 4)))
DI int v_rd_base(int lane) { return ((lane & 3) << 3) | (((lane >> 2) & 3) << 6) | (((lane >> 4) & 1) << 5) | (((lane >> 5) & 1) << 8); }
constexpr int v_rd_off(int d0, int ks, int half) { return d0 * 512 + ks * 8192 + half * 4096; }
template <int OFF> DI s16x4 tr_read(int vb) { s16x4 r; asm volatile("ds_read_b64_tr_b16 %0, %1 offset:%2" : "=&v"(r) : "v"(vb), "i"(OFF) : "memory"); return r; }
template <int D0> DI void pv_two(f32x16& oa, f32x16& ob, int vb, bf16x8 pa0, bf16x8 pa1) {
    const s16x4 l0 = tr_read<v_rd_off(D0, 0, 0)>(vb), h0 = tr_read<v_rd_off(D0, 0, 1)>(vb), l1 = tr_read<v_rd_off(D0, 1, 0)>(vb), h1 = tr_read<v_rd_off(D0, 1, 1)>(vb);
    const s16x4 l2 = tr_read<v_rd_off(D0 + 1, 0, 0)>(vb), h2 = tr_read<v_rd_off(D0 + 1, 0, 1)>(vb), l3 = tr_read<v_rd_off(D0 + 1, 1, 0)>(vb), h3 = tr_read<v_rd_off(D0 + 1, 1, 1)>(vb);
    asm volatile("s_waitcnt lgkmcnt(0)" ::: "memory"); __builtin_amdgcn_sched_barrier(0);
    oa = MFMA32(pa0, PK8(l0, h0), oa);
    ob = MFMA32(pa0, PK8(l2, h2), ob);
    oa = MFMA32(pa1, PK8(l1, h1), oa);
    ob = MFMA32(pa1, PK8(l3, h3), ob);
    __builtin_amdgcn_sched_barrier(0);
}
DI void attn_stage(const bf16_t* kbase, const bf16_t* vbase, unsigned koff, unsigned voff, LAS unsigned char* ldsbuf, int wid) {
#pragma unroll
    for (int i = 0; i < 2; ++i) {
        const char* src = (const char*)kbase + (size_t)(i * 128) * 2;
        __builtin_amdgcn_global_load_lds((const unsigned*)(src + koff), (LAS unsigned*)(ldsbuf + (wid + 8 * i) * 1024), 16, 0, 0);
    }
#pragma unroll
    for (int i = 0; i < 2; ++i) {
        const char* src = (const char*)vbase + (size_t)(16 * i * 2048) * 2;
        __builtin_amdgcn_global_load_lds((const unsigned*)(src + voff), (LAS unsigned*)(ldsbuf + 16384 + (wid + 8 * i) * 1024), 16, 0, 0);
    }
}
DI void finalize_attn(const Params& p, unsigned char* lds, f32x16 (&o)[8], float l_reg, int lane_k, int wid, bool meta, int qrow0, int hh, int di, float lambda_init, bool dry) {
    int lane = (lane_k < 0) ? hw_lane() : lane_k; asm volatile("" : "+v"(lane));
    const int r32 = lane & 31, hi = lane >> 5, rg = wid & 3, psub = wid >> 2;
    float* wsx = (float*)(lds + 132096) + wid * 64; float* li_l = wsx; const float* misc = (const float*)(lds + 134144);
    float* X = (float*)lds; bf16_t* qbuf = (bf16_t*)(p.ws + WS_ACT);
    if (hi == 0) li_l[r32] = l_reg;
    asm volatile("s_waitcnt lgkmcnt(0)" ::: "memory");
    {
        const float sc = psub ? -misc[0] : 1.f;
#pragma unroll
        for (int r = 0; r < 16; ++r) {
            const float c = sc / li_l[crow(r, hi)];
#pragma unroll
            for (int d = 0; d < 8; ++d) o[d][r] *= c;
        }
    }
    __syncthreads();
    if (psub == 1) {
#pragma unroll
        for (int d = 0; d < 8; ++d)
#pragma unroll
            for (int r = 0; r < 16; ++r) X[(rg * 128 + d * 16 + r) * 64 + lane] = o[d][r];
    }
    __syncthreads();
    if (psub == 0) {
#pragma unroll
        for (int d = 0; d < 8; ++d)
#pragma unroll
            for (int r = 0; r < 16; ++r) o[d][r] += X[(rg * 128 + d * 16 + r) * 64 + lane];
        asm volatile("s_waitcnt lgkmcnt(0)" ::: "memory");
        float* R = (float*)(lds + rg * 32768);
#pragma unroll
        for (int d = 0; d < 8; ++d)
#pragma unroll
            for (int r = 0; r < 16; ++r) R[crow(r, hi) * 256 + 32 * d + r32] = o[d][r];
        asm volatile("s_waitcnt lgkmcnt(0)" ::: "memory");
        const float og = 1.f - misc[1]; const int c8 = (lane & 31) * 8;
        const f32x4 g0 = *(const f32x4*)(p.diff_gn + (size_t)di * 256 + c8) * og, g1 = *(const f32x4*)(p.diff_gn + (size_t)di * 256 + c8 + 4) * og;
        bf16_t* dstb = qbuf + (size_t)(qrow0 + 32 * rg + (lane >> 5)) * 2048 + hh * 256 + c8;
        const int nrow = dry ? 0 : (meta ? (rg == 0 ? 16 : 0) : 32);
#pragma unroll 2
        for (int it = 0; it < 16; ++it) {
            const int row = 2 * it + (lane >> 5);
            f32x4 a = *(const f32x4*)(R + row * 256 + c8), b = *(const f32x4*)(R + row * 256 + c8 + 4);
            float ss = a[0] * a[0] + a[1] * a[1] + a[2] * a[2] + a[3] * a[3] + b[0] * b[0] + b[1] * b[1] + b[2] * b[2] + b[3] * b[3];
            ss = half_sum(ss);
            const float rstd = rsqrtf(ss * (1.f / 256.f) + 1e-6f);
            a = a * rstd * g0; b = b * rstd * g1;
            u32x4 w; w.x = cvt_pk_bf16(a[0], a[1]); w.y = cvt_pk_bf16(a[2], a[3]); w.z = cvt_pk_bf16(b[0], b[1]); w.w = cvt_pk_bf16(b[2], b[3]);
            if (row < nrow) *(u32x4*)(dstb + (size_t)it * 4096) = w;
        }
    }
}
DI void phase_attn(int wid0, const Params& p, int L, unsigned char* lds, bool dry) {
    const int di = L >> 1; const float lambda_init = 0.8f - 0.6f * __expf(-0.3f * (float)L);
    const int tid = opaque_tid(wid0), wid = __builtin_amdgcn_readfirstlane(tid >> 6), lane_k = tid & 63, rg = wid & 3, psub = wid >> 2;
    LAS unsigned char* ldsl = (LAS unsigned char*)lds;
    float* tab = (float*)(lds + 131072); float* wsx = (float*)(lds + 132096) + wid * 64; float* li_l = wsx; float* al_l = wsx + 32; float* misc = (float*)(lds + 134144);
    float* X = (float*)lds;
    bf16_t* act = (bf16_t*)(p.ws + WS_ACT); bf16_t* qbuf = act; const bf16_t* kbuf = act + RALLOC * 2048; const bf16_t* vbuf = act + RALLOC * 4096;
    const float* biasT = (const float*)(p.ws + WS_BIAS);
    if (wid == 0) {
        const float* lv = p.diff_lam + (size_t)di * 512;
        const int lane = lane_k; float s1 = lv[lane] * lv[128 + lane] + lv[64 + lane] * lv[192 + lane], s2 = lv[256 + lane] * lv[384 + lane] + lv[320 + lane] * lv[448 + lane];
        s1 = wave_sum(s1); s2 = wave_sum(s2);
        if (lane == 0) { misc[0] = __expf(s1) - __expf(s2) + lambda_init; misc[1] = lambda_init; }
    }
    __syncthreads();
    const int G = opaque_gdim(), blk = opaque_bid();
    for (int ui = 0;; ++ui) {
        int b, hh, qb; bool meta = false;
        int lane = lane_k; asm volatile("" : "+v"(lane));
        const int r32 = lane & 31, hi = lane >> 5;
        unsigned koff, voff;
        { const int row = 4 * wid + (lane >> 4), gsrc = (lane & 15) ^ (row & 7); koff = (unsigned)(row * 2048 + 8 * gsrc) * 2u;
          const int w5 = (lane & 31) >> 2, kl = (w5 & 3) + 8 * (w5 >> 2) + 4 * (wid >> 2), col = ((2 * wid + (lane >> 5)) & 7) * 32 + (lane & 3) * 8; voff = (unsigned)(kl * 2048 + col) * 2u; }

        if (G == 256) {
            if (ui < 8) { const int bh = 8 * ui + (blk & 7), j = blk >> 3; qb = (ui & 1) ? 31 - j : j; b = bh >> 3; hh = bh & 7; }
            else if (ui == 8 && blk < 8) { meta = true; hh = blk; b = 0; qb = 0; }
            else break;
        } else {
            const int u = blk + ui * G;
            if (u < 2048) { const int bh = u & 63; qb = 31 - (u >> 6); b = bh >> 3; hh = bh & 7; }
            else if (u < 2056) { meta = true; hh = u - 2048; b = 0; qb = 0; }
            else break;
        }
        const int qrow0 = meta ? MREG : b * 4096 + 128 * qb, qpos0 = meta ? 0 : 16 + 128 * qb, ntiles = meta ? 1 : 1 + 4 * (qb + 1);
        if (tid < 130) tab[tid] = (tid < 129) ? biasT[hh * 129 + tid] : -__builtin_inff();
        int myrow = qrow0 + 32 * rg + r32; if (meta && myrow > MREG + 63) myrow = MREG + 63;
        const bf16_t* qp = qbuf + (size_t)myrow * 2048 + hh * 256 + psub * 128 + hi * 8;
        unsigned char* qlds = lds + wid * 8192 + lane * 16;
#pragma unroll
        for (int d0 = 0; d0 < 8; ++d0) *(bf16x8*)(qlds + d0 * 1024) = *(const bf16x8*)(qp + d0 * 16);
        const int wq0 = qpos0 + 32 * rg, qpos = wq0 + r32;
        const bf16_t* kh_ = kbuf + hh * 256; const bf16_t* vh_ = vbuf + hh * 256;
        attn_stage(kh_ + (size_t)MREG * 2048, vh_ + (size_t)MREG * 2048, koff, voff, ldsl + 65536, wid);
        f32x16 o[8];
#pragma unroll
        for (int d = 0; d < 8; ++d)
#pragma unroll
            for (int r = 0; r < 16; ++r) o[d][r] = 0.f;
        float m_reg = -1e30f, l_reg = 0.f;
        for (int t = 0; t < ntiles; ++t) {
            asm volatile("s_waitcnt vmcnt(0) lgkmcnt(0)" ::: "memory"); __builtin_amdgcn_s_barrier(); asm volatile("" ::: "memory");
            if (t + 1 < ntiles) attn_stage(kh_ + (size_t)(b * 4096 + 32 * t) * 2048, vh_ + (size_t)(b * 4096 + 32 * t) * 2048, koff, voff, ldsl + 65536 + ((t + 1) & 1) * 32768, wid);
            const int kpos0 = (t == 0) ? 0 : 16 + 32 * (t - 1);
            if (kpos0 <= wq0 + 31) {
                const unsigned char* Ks = lds + 65536 + (t & 1) * 32768 + psub * 8192;
                f32x16 p0, p0b;
#pragma unroll
                for (int r = 0; r < 16; ++r) { p0[r] = 0.f; p0b[r] = 0.f; }
                int swz = (r32 & 6) << 4, kro = r32 * 256 + ((hi ^ (r32 & 1)) << 4); asm volatile("" : "+v"(swz), "+v"(kro));
#pragma unroll
                for (int d0 = 0; d0 < 8; d0 += 2) {
                    const bf16x8 b0 = *(const bf16x8*)(Ks + kro + ((d0 * 32) ^ swz));
                    const bf16x8 qf = *(const bf16x8*)(qlds + d0 * 1024);
                    const bf16x8 b1 = *(const bf16x8*)(Ks + kro + (((d0 + 1) * 32) ^ swz));
                    const bf16x8 qg = *(const bf16x8*)(qlds + (d0 + 1) * 1024);
                    p0 = MFMA32(b0, qf, p0);
                    p0b = MFMA32(b1, qg, p0b);
                    if (d0 == 2) __builtin_amdgcn_sched_barrier(0);
                }
#pragma unroll
                for (int r = 0; r < 16; ++r) p0[r] += p0b[r];
                __builtin_amdgcn_sched_barrier(0);
                if (t > 0 && wq0 - (kpos0 + 31) >= 128) {
                    const float bfar = tab[128];
#pragma unroll
                    for (int r = 0; r < 16; ++r) p0[r] = fmaf(p0[r], ATT_C, bfar);
                } else {
#pragma unroll
                    for (int r = 0; r < 16; ++r) {
                        const int k0i = crow(r, hi);
                        const int d0v = qpos - (kpos0 + k0i);
                        const bool v0 = (d0v >= 0) && (t > 0 || k0i < 16);
                        const int idx = v0 ? (d0v < 128 ? d0v : 128) : 129;
                        p0[r] = fmaf(p0[r], ATT_C, tab[idx]);
                        if ((r & 3) == 3) __builtin_amdgcn_sched_barrier(0);
                    }
                }
                __builtin_amdgcn_sched_barrier(0);
                float pmax = p0[0];
#pragma unroll
                for (int r = 1; r < 16; ++r) pmax = fmaxf(pmax, p0[r]);
                { auto rr = __builtin_amdgcn_permlane32_swap(__float_as_uint(pmax), __float_as_uint(pmax), false, false); pmax = fmaxf(__uint_as_float(rr[0]), __uint_as_float(rr[1])); }
                float mn, alpha;
                if (__all(pmax - m_reg <= ATT_THR2)) { mn = m_reg; alpha = 1.f; }
                else { mn = fmaxf(m_reg, pmax); alpha = __builtin_amdgcn_exp2f(m_reg - mn); m_reg = mn; }
                float ps = 0.f;
#pragma unroll
                for (int r = 0; r < 16; ++r) { p0[r] = __builtin_amdgcn_exp2f(p0[r] - mn); ps += p0[r]; }
                { auto rr = __builtin_amdgcn_permlane32_swap(__float_as_uint(ps), __float_as_uint(ps), false, false); ps = __uint_as_float(rr[0]) + __uint_as_float(rr[1]); }
                l_reg = l_reg * alpha + ps;
                __builtin_amdgcn_sched_barrier(0);
                bf16x8 pa0, pa1;
#define PK4(P, BASE, OUT) do { unsigned a0 = cvt_pk_bf16(P[BASE + 0], P[BASE + 1]), a1 = cvt_pk_bf16(P[BASE + 2], P[BASE + 3]);   \
    unsigned b0_ = cvt_pk_bf16(P[BASE + 4], P[BASE + 5]), b1_ = cvt_pk_bf16(P[BASE + 6], P[BASE + 7]);                              \
    auto r0 = __builtin_amdgcn_permlane32_swap(a0, b0_, false, false); auto r1 = __builtin_amdgcn_permlane32_swap(a1, b1_, false, false); \
    u32x4 w_ = {r0[0], r1[0], r0[1], r1[1]}; OUT = __builtin_bit_cast(bf16x8, w_); } while (0)
                PK4(p0, 0, pa0); PK4(p0, 8, pa1);
#undef PK4
                __builtin_amdgcn_sched_barrier(0);
                if (__any(alpha < 1.f)) {
                    if (hi == 0) al_l[r32] = alpha;
                    asm volatile("s_waitcnt lgkmcnt(0)" ::: "memory");
                    float ar[16];
#pragma unroll
                    for (int r = 0; r < 16; ++r) ar[r] = al_l[crow(r, hi)];
#pragma unroll
                    for (int d = 0; d < 8; ++d)
#pragma unroll
                        for (int r = 0; r < 16; ++r) o[d][r] *= ar[r];
                }
                __builtin_amdgcn_sched_barrier(0);
                LAS unsigned char* vbp = ldsl + 65536 + (t & 1) * 32768 + 16384 + v_rd_base(lane);
                __builtin_amdgcn_s_setprio(1);
#define TRB(OFF) __builtin_amdgcn_ds_read_tr16_b64_v4i16((LAS s16x4*)(vbp + (OFF)))
#define PV_RD(D0, L0, H0, L1, H1) L0 = TRB(v_rd_off(D0, 0, 0)); H0 = TRB(v_rd_off(D0, 0, 1)); L1 = TRB(v_rd_off(D0, 1, 0)); H1 = TRB(v_rd_off(D0, 1, 1))
#define PV_MM(D0, L0, H0, L1, H1) o[D0] = MFMA32(pa0, PK8(L0, H0), o[D0]); o[D0] = MFMA32(pa1, PK8(L1, H1), o[D0])
#define SB() __builtin_amdgcn_sched_barrier(0)
                {
                    s16x4 a0, a1, a2, a3, b0_, b1_, b2_, b3_;
                    PV_RD(0, a0, a1, a2, a3); SB();
                    PV_RD(1, b0_, b1_, b2_, b3_); SB(); PV_MM(0, a0, a1, a2, a3); SB();
                    PV_RD(2, a0, a1, a2, a3); SB(); PV_MM(1, b0_, b1_, b2_, b3_); SB();
                    PV_RD(3, b0_, b1_, b2_, b3_); SB(); PV_MM(2, a0, a1, a2, a3); SB();
                    PV_RD(4, a0, a1, a2, a3); SB(); PV_MM(3, b0_, b1_, b2_, b3_); SB();
                    PV_RD(5, b0_, b1_, b2_, b3_); SB(); PV_MM(4, a0, a1, a2, a3); SB();
                    PV_RD(6, a0, a1, a2, a3); SB(); PV_MM(5, b0_, b1_, b2_, b3_); SB();
                    PV_RD(7, b0_, b1_, b2_, b3_); SB(); PV_MM(6, a0, a1, a2, a3); SB();
                    PV_MM(7, b0_, b1_, b2_, b3_); SB();
                }
#undef TRB
#undef PV_RD
#undef PV_MM
#undef SB
                __builtin_amdgcn_s_setprio(0);
            }
        }
        finalize_attn(p, lds, o, l_reg, lane_k, wid, meta, qrow0, hh, di, lambda_init, dry);
        __syncthreads();
    }
}


DI void attn_stage64(const bf16_t* kbase, const bf16_t* vbase, unsigned koff, unsigned voff, LAS unsigned char* ldsbuf, int wid) {
#pragma unroll
    for (int i = 0; i < 4; ++i) {
        const unsigned off = koff + (unsigned)((32 * (i & 1)) * 2048 + (i >> 1) * 128) * 2u;
        __builtin_amdgcn_global_load_lds((const unsigned*)((const char*)kbase + off), (LAS unsigned*)(ldsbuf + (wid + 8 * i) * 1024), 16, 0, 0);
    }
#pragma unroll
    for (int i = 0; i < 4; ++i) {
        const unsigned off = voff + (unsigned)(16 * i * 2048) * 2u;
        __builtin_amdgcn_global_load_lds((const unsigned*)((const char*)vbase + off), (LAS unsigned*)(ldsbuf + 32768 + (wid + 8 * i) * 1024), 16, 0, 0);
    }
}
template <int D0, int KH> DI void pv_two64(f32x16& oa, f32x16& ob, int vb, bf16x8 pa0, bf16x8 pa1) {
    const s16x4 l0 = tr_read<v_rd_off(D0, 2 * KH, 0)>(vb), h0 = tr_read<v_rd_off(D0, 2 * KH, 1)>(vb), l1 = tr_read<v_rd_off(D0, 2 * KH + 1, 0)>(vb), h1 = tr_read<v_rd_off(D0, 2 * KH + 1, 1)>(vb);
    const s16x4 l2 = tr_read<v_rd_off(D0 + 1, 2 * KH, 0)>(vb), h2 = tr_read<v_rd_off(D0 + 1, 2 * KH, 1)>(vb), l3 = tr_read<v_rd_off(D0 + 1, 2 * KH + 1, 0)>(vb), h3 = tr_read<v_rd_off(D0 + 1, 2 * KH + 1, 1)>(vb);
    asm volatile("s_waitcnt lgkmcnt(0)" ::: "memory"); __builtin_amdgcn_sched_barrier(0);
    oa = MFMA32(pa0, PK8(l0, h0), oa);
    ob = MFMA32(pa0, PK8(l2, h2), ob);
    oa = MFMA32(pa1, PK8(l1, h1), oa);
    ob = MFMA32(pa1, PK8(l3, h3), ob);
    __builtin_amdgcn_sched_barrier(0);
}
template <int KH> DI void attn_half(f32x16 (&o)[8], const bf16x8 (&qr)[8], float& m_reg, float& l_reg, const unsigned char* Ks, int vb0, const float* tab, float* al_l,
                                    int r32, int hi, int qpos, int wq0, int kpos0, bool t0) {
    if (kpos0 > wq0 + 31) return;
    f32x16 p0;
#pragma unroll
    for (int r = 0; r < 16; ++r) p0[r] = 0.f;
    int swz = (r32 & 6) << 4, kro = (32 * KH + r32) * 256 + ((hi ^ (r32 & 1)) << 4); asm volatile("" : "+v"(swz), "+v"(kro));
#pragma unroll
    for (int d0 = 0; d0 < 8; ++d0) {
        const bf16x8 b0 = *(const bf16x8*)(Ks + kro + ((d0 * 32) ^ swz));
        p0 = MFMA32(b0, qr[d0], p0);
        if (d0 == 3) __builtin_amdgcn_sched_barrier(0);
    }
    __builtin_amdgcn_sched_barrier(0);
    if (!t0 && wq0 - (kpos0 + 31) >= 128) {
        const float bfar = tab[128];
#pragma unroll
        for (int r = 0; r < 16; ++r) p0[r] = fmaf(p0[r], ATT_C, bfar);
    } else {
#pragma unroll
        for (int r = 0; r < 16; ++r) {
            const int k0i = crow(r, hi);
            const int d0v = qpos - (kpos0 + k0i);
            const bool v0 = (d0v >= 0) && (!t0 || k0i < 16);
            const int idx = v0 ? (d0v < 128 ? d0v : 128) : 129;
            p0[r] = fmaf(p0[r], ATT_C, tab[idx]);
            if ((r & 3) == 3) __builtin_amdgcn_sched_barrier(0);
        }
    }
    __builtin_amdgcn_sched_barrier(0);
    float pmax = p0[0];
#pragma unroll
    for (int r = 1; r < 16; ++r) pmax = fmaxf(pmax, p0[r]);
    { auto rr = __builtin_amdgcn_permlane32_swap(__float_as_uint(pmax), __float_as_uint(pmax), false, false); pmax = fmaxf(__uint_as_float(rr[0]), __uint_as_float(rr[1])); }
    float mn, alpha;
    if (__all(pmax - m_reg <= ATT_THR2)) { mn = m_reg; alpha = 1.f; }
    else { mn = fmaxf(m_reg, pmax); alpha = __builtin_amdgcn_exp2f(m_reg - mn); m_reg = mn; }
    float ps = 0.f;
#pragma unroll
    for (int r = 0; r < 16; ++r) { p0[r] = __builtin_amdgcn_exp2f(p0[r] - mn); ps += p0[r]; }
    { auto rr = __builtin_amdgcn_permlane32_swap(__float_as_uint(ps), __float_as_uint(ps), false, false); ps = __uint_as_float(rr[0]) + __uint_as_float(rr[1]); }
    l_reg = l_reg * alpha + ps;
    __builtin_amdgcn_sched_barrier(0);
    bf16x8 pa0, pa1;
#define PK4(P, BASE, OUT) do { unsigned a0 = cvt_pk_bf16(P[BASE + 0], P[BASE + 1]), a1 = cvt_pk_bf16(P[BASE + 2], P[BASE + 3]);   \
    unsigned b0_ = cvt_pk_bf16(P[BASE + 4], P[BASE + 5]), b1_ = cvt_pk_bf16(P[BASE + 6], P[BASE + 7]);                              \
    auto r0 = __builtin_amdgcn_permlane32_swap(a0, b0_, false, false); auto r1 = __builtin_amdgcn_permlane32_swap(a1, b1_, false, false); \
    u32x4 w_ = {r0[0], r1[0], r0[1], r1[1]}; OUT = __builtin_bit_cast(bf16x8, w_); } while (0)
    PK4(p0, 0, pa0); PK4(p0, 8, pa1);
#undef PK4
    __builtin_amdgcn_sched_barrier(0);
    if (__any(alpha < 1.f)) {
        if (hi == 0) al_l[r32] = alpha;
        asm volatile("s_waitcnt lgkmcnt(0)" ::: "memory");
        float ar[16];
#pragma unroll
        for (int r = 0; r < 16; ++r) ar[r] = al_l[crow(r, hi)];
#pragma unroll
        for (int d = 0; d < 8; ++d)
#pragma unroll
            for (int r = 0; r < 16; ++r) o[d][r] *= ar[r];
    }
    __builtin_amdgcn_sched_barrier(0);
    pv_two64<0, KH>(o[0], o[1], vb0, pa0, pa1); pv_two64<2, KH>(o[2], o[3], vb0, pa0, pa1); pv_two64<4, KH>(o[4], o[5], vb0, pa0, pa1); pv_two64<6, KH>(o[6], o[7], vb0, pa0, pa1);
}
DI void phase_attn64(int wid0, const Params& p, int L, unsigned char* lds, bool dry) {
    const int di = L >> 1; const float lambda_init = 0.8f - 0.6f * __expf(-0.3f * (float)L);
    const int tid = opaque_tid(wid0), wid = __builtin_amdgcn_readfirstlane(tid >> 6), lane_k = tid & 63, rg = wid & 3, psub = wid >> 2;
    LAS unsigned char* ldsl = (LAS unsigned char*)lds;
    float* tab = (float*)(lds + 131072); float* wsx = (float*)(lds + 132096) + wid * 64; float* al_l = wsx + 32; float* misc = (float*)(lds + 134144);
    bf16_t* act = (bf16_t*)(p.ws + WS_ACT); bf16_t* qbuf = act; const bf16_t* kbuf = act + RALLOC * 2048; const bf16_t* vbuf = act + RALLOC * 4096;
    const float* biasT = (const float*)(p.ws + WS_BIAS);
    if (wid == 0) {
        const float* lv = p.diff_lam + (size_t)di * 512;
        const int lane = lane_k; float s1 = lv[lane] * lv[128 + lane] + lv[64 + lane] * lv[192 + lane], s2 = lv[256 + lane] * lv[384 + lane] + lv[320 + lane] * lv[448 + lane];
        s1 = wave_sum(s1); s2 = wave_sum(s2);
        if (lane == 0) { misc[0] = __expf(s1) - __expf(s2) + lambda_init; misc[1] = lambda_init; }
    }
    __syncthreads();
    const int blk = opaque_bid();
    for (int ui = 0;; ++ui) {
        int b, hh, qb; bool meta = false;
        int lane = hw_lane(); asm volatile("" : "+v"(lane));
        const int r32 = lane & 31, hi = lane >> 5;
#define ATT_OFFS(LN) unsigned koff, voff; { int ln_ = (LN); asm volatile("" : "+v"(ln_)); const int row = 4 * wid + (ln_ >> 4), gsrc = (ln_ & 15) ^ (row & 7); koff = (unsigned)(row * 2048 + 8 * gsrc) * 2u; \
          const int w5 = (ln_ & 31) >> 2, kl = (w5 & 3) + 8 * (w5 >> 2) + 4 * (wid >> 2), col = ((2 * wid + (ln_ >> 5)) & 7) * 32 + (ln_ & 3) * 8; voff = (unsigned)(kl * 2048 + col) * 2u; }
        if (ui < 8) { const int bh = 8 * ui + (blk & 7), j = (blk >> 3) & 31; qb = (ui & 1) ? 31 - j : j; b = bh >> 3; hh = bh & 7; }
        else if (ui == 8 && blk < 8) { meta = true; hh = blk; b = 0; qb = 0; }
        else break;
        const int qrow0 = meta ? MREG : b * 4096 + 128 * qb, qpos0 = meta ? 0 : 16 + 128 * qb, ntiles = meta ? 1 : 1 + 2 * (qb + 1);
        { const int t_ = wid * 64 + lane; if (t_ < 130) tab[t_] = (t_ < 129) ? biasT[hh * 129 + t_] : -__builtin_inff(); }
        __builtin_amdgcn_sched_barrier(0);
        int myrow = qrow0 + 32 * rg + r32; if (meta && myrow > MREG + 63) myrow = MREG + 63;
        const bf16_t* qp = qbuf + (size_t)myrow * 2048 + hh * 256 + psub * 128 + hi * 8;
        bf16x8 qr[8];
#pragma unroll
        for (int d0 = 0; d0 < 8; ++d0) qr[d0] = *(const bf16x8*)(qp + d0 * 16);
        __builtin_amdgcn_sched_barrier(0);
        const int wq0 = qpos0 + 32 * rg, qpos = wq0 + r32;
        const bf16_t* kh_ = kbuf + hh * 256; const bf16_t* vh_ = vbuf + hh * 256;
        { ATT_OFFS(lane); attn_stage64(kh_ + (size_t)MREG * 2048, vh_ + (size_t)MREG * 2048, koff, voff, ldsl, wid); }
        __builtin_amdgcn_sched_barrier(0);
        f32x16 o[8];
#pragma unroll
        for (int d = 0; d < 8; ++d)
#pragma unroll
            for (int r = 0; r < 16; ++r) o[d][r] = 0.f;
        float m_reg = -1e30f, l_reg = 0.f;
        for (int t = 0; t < ntiles; ++t) {
            asm volatile("s_waitcnt vmcnt(0) lgkmcnt(0)" ::: "memory"); __builtin_amdgcn_s_barrier(); asm volatile("" ::: "memory");
            if (t + 1 < ntiles) { ATT_OFFS(lane); attn_stage64(kh_ + (size_t)(b * 4096 + 64 * t) * 2048, vh_ + (size_t)(b * 4096 + 64 * t) * 2048, koff, voff, ldsl + ((t + 1) & 1) * 65536, wid); }
            const int kpos0 = (t == 0) ? 0 : 16 + 64 * (t - 1);
            const unsigned char* Ks = lds + (t & 1) * 65536 + psub * 16384;
            const int vb0 = (int)(unsigned)(size_t)(ldsl + (t & 1) * 65536 + 32768) + v_rd_base(lane);
            attn_half<0>(o, qr, m_reg, l_reg, Ks, vb0, tab, al_l, r32, hi, qpos, wq0, kpos0, t == 0);
            if (t > 0) attn_half<1>(o, qr, m_reg, l_reg, Ks, vb0, tab, al_l, r32, hi, qpos, wq0, kpos0 + 32, false);
        }
        finalize_attn(p, lds, o, l_reg, -1, wid, meta, qrow0, hh, di, lambda_init, dry);
        __syncthreads();
    }
}

#define XB_TMO      128
#define XB_XCNT(j)  (256  + 64 * (j))
#define XB_XSUB(j)  (1280 + 64 * (j))
#define XB_XGEN(j)  (2304 + 64 * (j))
#define XB_TOP      3328
#define XB_TOPGEN   3392
#define XCD_BAR_WORDS 3456
#define XB_SPIN_CAP (1u << 22)
DI unsigned xb_ld(unsigned* p)              { return __hip_atomic_load(p, __ATOMIC_RELAXED, __HIP_MEMORY_SCOPE_AGENT); }
DI unsigned xb_add(unsigned* p, unsigned v) { return __hip_atomic_fetch_add(p, v, __ATOMIC_RELAXED, __HIP_MEMORY_SCOPE_AGENT); }
DI unsigned xb_xcc_id() { return (unsigned)__builtin_amdgcn_s_getreg((3 << 11) | 20) & 0xFu; }
#define XB_SPIN(cond, bar) do { unsigned _sp = 0; while (cond) { __builtin_amdgcn_s_sleep(1); \
    if ((++_sp & 255u) == 0u) { if (xb_ld(&(bar)[XB_TMO])) break; if (_sp > XB_SPIN_CAP) { atomicAdd(&(bar)[XB_TMO], 1u); break; } } } } while (0)
struct XcdBarrier { unsigned* bar; unsigned x; volatile LAS unsigned* st; };
DI XcdBarrier xcd_barrier_post(int wid0, unsigned* bar, volatile LAS unsigned* st) {
    XcdBarrier b; b.bar = bar; b.x = xb_xcc_id(); b.st = st;
    if (wid0 == 0 && hw_lane() == 0) (void)xb_add(&bar[XB_XCNT(b.x)], 1u);
    return b;
}
DI void xcd_barrier_complete(unsigned* bar, unsigned x, unsigned& nloc, unsigned& nx) {
    const unsigned G = (unsigned)opaque_gdim();
    unsigned sum, cnt, mine, sp = 0u;
    for (;;) {
        sum = 0u; cnt = 0u; mine = 0u;
#pragma unroll
        for (unsigned j = 0; j < 16; ++j) { const unsigned c = xb_ld(&bar[XB_XCNT(j)]); sum += c; cnt += (c > 0u) ? 1u : 0u; mine = (j == x) ? c : mine; }
        if (sum == G) break;
        __builtin_amdgcn_s_sleep(1);
        if ((++sp & 255u) == 0u) { if (xb_ld(&bar[XB_TMO])) break; if (sp > XB_SPIN_CAP) { atomicAdd(&bar[XB_TMO], 1u); break; } }
    }
    nloc = mine > 0u ? mine : 1u; nx = cnt > 0u ? cnt : 1u;
}
DI void xcd_barrier(int wid0, const XcdBarrier& b) {
    asm volatile("s_waitcnt vmcnt(0)" ::: "memory");
    __syncthreads();
    if (wid0 == 0 && hw_lane() == 0) {
        unsigned* bar = b.bar;
        __builtin_amdgcn_s_waitcnt(0);
        unsigned nloc = b.st[0], nx = b.st[1];
        if (nloc == 0u) { xcd_barrier_complete(bar, b.x, nloc, nx); b.st[0] = nloc; b.st[1] = nx; }
        const unsigned old = xb_add(&bar[XB_XSUB(b.x)], 1u);
        const unsigned gen = old / nloc;
        if (old + 1u == (gen + 1u) * nloc) {
            __builtin_amdgcn_fence(__ATOMIC_RELEASE, "agent");
            asm volatile("s_waitcnt vmcnt(0)" ::: "memory");
            const unsigned og = xb_add(&bar[XB_TOP], 1u);
            const unsigned tg = og / nx;
            if (og + 1u == (tg + 1u) * nx) xb_add(&bar[XB_TOPGEN], 1u);
            else XB_SPIN(xb_ld(&bar[XB_TOPGEN]) == tg, bar);
            __builtin_amdgcn_fence(__ATOMIC_ACQUIRE, "agent");
            xb_add(&bar[XB_XGEN(b.x)], 1u);
            asm volatile("s_waitcnt vmcnt(0)" ::: "memory");
        } else {
            XB_SPIN(xb_ld(&bar[XB_XGEN(b.x)]) == gen, bar);
            __builtin_amdgcn_fence(__ATOMIC_ACQUIRE, "agent");
            asm volatile("s_waitcnt vmcnt(0)" ::: "memory");
        }
    }
    __syncthreads();
}

__global__ void __launch_bounds__(512) mega(Params p_arg) {
    extern __shared__ __attribute__((aligned(16))) unsigned char lds[];
    cg::grid_group grid = cg::this_grid();
    const int ph_lo = p_arg.ph_lo, ph_hi = p_arg.ph_hi;
    if (ph_lo < 0) grid.sync();
    volatile LAS unsigned* xbst = (volatile LAS unsigned*)(LAS unsigned char*)(lds + LDS_BYTES - 16);
    const int wid0 = __builtin_amdgcn_readfirstlane((int)(threadIdx.x >> 6));
    if (wid0 == 0 && hw_lane() == 0) { xbst[0] = 0u; xbst[1] = 0u; }
    __syncthreads();
    XcdBarrier xb; xb.bar = (unsigned*)(p_arg.ws + WS_BAR); xb.x = 0; xb.st = xbst;
    if (ph_hi - ph_lo > 1) xb = xcd_barrier_post(wid0, (unsigned*)(p_arg.ws + WS_BAR), xbst);
    for (int ph = ph_lo; ph < ph_hi; ++ph) {
        const __attribute__((address_space(4))) Params* pp = (const __attribute__((address_space(4))) Params*)__builtin_amdgcn_kernarg_segment_ptr();
        asm volatile("" : "+s"(pp));
        Params p;
        p.x = pp->x; p.meta = pp->meta; p.g_norm = pp->g_norm; p.gla_w_in = pp->gla_w_in; p.gla_wgu = pp->gla_wgu; p.gla_bg = pp->gla_bg; p.gla_gn = pp->gla_gn; p.gla_w_out = pp->gla_w_out;
        p.diff_w_in = pp->diff_w_in; p.diff_lam = pp->diff_lam; p.diff_gn = pp->diff_gn; p.diff_w_out = pp->diff_w_out; p.rel_bias = pp->rel_bias; p.g_final = pp->g_final; p.out = pp->out; p.ws = pp->ws;
        p.ph_lo = ph_lo; p.ph_hi = ph_hi;
        bf16_t* act = (bf16_t*)(p.ws + WS_ACT); const bf16_t* hn = (const bf16_t*)(p.ws + WS_HN);
        const bf16_t* win = (const bf16_t*)(p.ws + WS_WIN); const bf16_t* wout = (const bf16_t*)(p.ws + WS_WOUT); const bf16_t* wg = (const bf16_t*)(p.ws + WS_WG);
        float* hmeta = (float*)(p.ws + WS_HMETA);
        const int G = opaque_gdim(), bid = opaque_bid();
        int L, kind;
        if (ph == 0) { L = 0; kind = 0; }
        else if (ph <= 6) { L = 0; kind = ph; }
        else if (ph <= 11) { L = 1; kind = ph; }
        else if (ph <= 17) { L = 2; kind = ph - 11; }
        else { L = 3; kind = ph - 11; }
        for (int rep = 0; rep < (((DBG_DOUBLE >> kind) & 1) && !(kind == 11 && L == 3) ? 2 : 1); ++rep) {
        if (EN(0) && kind == 0) { phase_bias(wid0, p); phase_norm(wid0, p, 0); phase_wconv(wid0, p, 0, lds); }
        else if (EN(1) && kind == 1) {
            pg8::Gemm g{hn, win, MREG, 6144, 1024}; pg8::StaticOrder S; S.init(MREG, 6144, G, bid);
            pg8::EpiGen<StGlaIn> E{StGlaIn{act}};
            pg8::gemm_phase(wid0, (LAS unsigned char*)lds, g, S, E);
            mini_gemm(wid0, hn, 1024, MREG, 4, win, 1024, 6144, StGlaIn{act});
            glr_gemm(wid0, hn, wg, (float*)(p.ws + WS_GLR));
        }
        else if (EN(2) && kind == 2) phase_prep(wid0, p, L, lds, DRY(rep));
        else if (EN(3) && kind == 3) phase_scan(wid0, p, lds, DRY(rep));
        else if (EN(4) && kind == 4) phase_gate(wid0, p, L, DRY(rep));
        else if (EN(5) && (kind == 5 || kind == 10)) {
            const bf16_t* A = (kind == 5) ? act + RALLOC * 4096 : act;
            const float* hsrc = (L == 0) ? p.x : p.out; const float* msrc = (L == 0) ? p.meta : hmeta;
            pg8::Gemm g{A, wout, MREG, 1024, 2048}; pg8::StaticOrder S; S.init(MREG, 1024, G, bid);
            pg8::EpiGen<StResid> E{StResid{hsrc, p.out, 0, DRY(rep)}};
            pg8::gemm_phase(wid0, (LAS unsigned char*)lds, g, S, E);
            mini_gemm(wid0, A, 2048, MREG, 1, wout, 2048, 1024, StResid{msrc, hmeta, MREG, DRY(rep)});
        }
        else if (EN(6) && (kind == 6 || kind == 11)) {
            if (L == 3) phase_final(wid0, p);
            else { phase_norm(wid0, p, L + 1); phase_wconv(wid0, p, L + 1, lds); }
        }
        else if (EN(7) && kind == 7) {
            pg8::Gemm g{hn, win, MREG, 6144, 1024}; pg8::StaticOrder S; S.init(MREG, 6144, G, bid);
            pg8::EpiGen<StDiffIn> E{StDiffIn{act}};
            pg8::gemm_phase(wid0, (LAS unsigned char*)lds, g, S, E);
            mini_gemm(wid0, hn, 1024, MREG, 4, win, 1024, 6144, StDiffIn{act});
        }
        else if (EN(8) && kind == 8) phase_attn(wid0, p, L, lds, DRY(rep));
        else if (EN(9) && kind == 9) {
            pg8::Gemm g{hn, win + (size_t)6144 * 1024, MREG, 2048, 1024}; pg8::StaticOrder S; S.init(MREG, 2048, G, bid);
            pg8::EpiGen<StZGate> E{StZGate{act, DRY(rep)}};
            pg8::gemm_phase(wid0, (LAS unsigned char*)lds, g, S, E);
            mini_gemm(wid0, hn, 1024, MREG, 1, win + (size_t)6144 * 1024, 1024, 2048, StZGate{act, DRY(rep)});
        }
        }
        if (ph + 1 < ph_hi) xcd_barrier(wid0, xb);
    }
}

extern "C" void kernel_launch(void* const* d_in, const int* in_sizes, int n_in, void* d_out, int out_size, void* d_ws, size_t ws_size, hipStream_t stream) {
    static int grid = 0;
    if (grid == 0) {
        if (ws_size < WS_END) { fprintf(stderr, "kernel_launch: workspace too small: %zu < %zu\n", ws_size, (size_t)WS_END); grid = -1; return; }
        int dev = 0, cus = 0, per_cu = 0;
        hipGetDevice(&dev); hipDeviceGetAttribute(&cus, hipDeviceAttributeMultiprocessorCount, dev);
        if (hipFuncSetAttribute((const void*)mega, hipFuncAttributeMaxDynamicSharedMemorySize, LDS_BYTES) != hipSuccess) { fprintf(stderr, "kernel_launch: hipFuncSetAttribute failed\n"); grid = -1; return; }
        if (hipOccupancyMaxActiveBlocksPerMultiprocessor(&per_cu, (const void*)mega, 512, LDS_BYTES) != hipSuccess || per_cu < 1) per_cu = 1;
        (void)hipGetLastError();
        grid = 256; (void)cus;
        if (grid <= 0) grid = 256;
    }
    if (grid < 0) return;
    Params p{};
    p.x = (const float*)d_in[0]; p.meta = (const float*)d_in[1]; p.g_norm = (const float*)d_in[2]; p.gla_w_in = (const float*)d_in[3]; p.gla_wgu = (const float*)d_in[4];
    p.gla_bg = (const float*)d_in[5]; p.gla_gn = (const float*)d_in[6]; p.gla_w_out = (const float*)d_in[7]; p.diff_w_in = (const float*)d_in[8]; p.diff_lam = (const float*)d_in[9];
    p.diff_gn = (const float*)d_in[10]; p.diff_w_out = (const float*)d_in[11]; p.rel_bias = (const float*)d_in[12]; p.g_final = (const float*)d_in[13];
    p.out = (float*)d_out; p.ws = (unsigned char*)d_ws;
    if (hipMemsetAsync((char*)d_ws + WS_BAR, 0, 16384, stream) != hipSuccess) { fprintf(stderr, "kernel_launch: memset failed\n"); return; }
#if MULTI_LAUNCH
#ifndef DBG_LAST
#define DBG_LAST 21
#endif
    for (int ph = 0; ph < NPHASES; ++ph) {
        if (ph > DBG_LAST && ph != NPHASES - 1) continue;
        if ((DBG_SKIP >> ph) & 1) continue;
        p.ph_lo = ph; p.ph_hi = ph + 1;
        hipLaunchKernelGGL(mega, dim3(grid), dim3(512), LDS_BYTES, stream, p);
    }
#else
    p.ph_lo = 0; p.ph_hi = NPHASES;
    void* args[] = {&p};
    hipError_t e = hipLaunchCooperativeKernel((void*)mega, dim3(grid), dim3(512), args, LDS_BYTES, stream);
    if (e != hipSuccess) fprintf(stderr, "cooperative launch failed: %s (grid %d)\n", hipGetErrorString(e), grid);
#endif
}
```
